# Optimizing an MI355X kernel written in HIP

```python
import jax
import jax.numpy as jnp
from jax import lax
import numpy as np

D_MODEL = 1024
BATCH = 8
SEQ = 2048
DEPTH = 2

CTX_LEN = 256
GRID_W = 64
N_EVEN = (DEPTH + 1) // 2
N_ODD = DEPTH // 2
EPS = 1e-6
CONV_K = 4
MIX_WIDTH = D_MODEL
RG_WIDTH = MIX_WIDTH // 2
RG_BLOCKS = 8
RG_BLOCK = RG_WIDTH // RG_BLOCKS
RG_C = 8.0
DN_HEADS = 4
DN_DK = MIX_WIDTH // (2 * DN_HEADS)
DN_DV = MIX_WIDTH // (2 * DN_HEADS)
DN_CHUNK = 64
HG_HEADS = 4
HG_DF = 128
HG_DI = MIX_WIDTH // (2 * HG_HEADS)
GLA_HEADS = 4
GLA_DK = 64
GLA_DV = MIX_WIDTH // (2 * GLA_HEADS)
GLA_RANK = 16
GLA_GATE_NORM = 16.0
GLA_CHUNK = 32
D_FF = 2816
N_EXPERTS = 8
TOP_K = 2
D_EXPERT = 2816

E_SIZES = (RG_WIDTH, RG_WIDTH, DN_HEADS * (2 * DN_DK + DN_DV), DN_HEADS * DN_DV, 2 * DN_HEADS, 2 * DN_HEADS)
E_IN = sum(E_SIZES)
O_SIZES = (HG_HEADS * HG_DF, HG_HEADS * HG_DF, HG_HEADS * HG_DF, HG_HEADS * HG_DI, HG_HEADS * HG_DI,
           GLA_HEADS * GLA_DK, GLA_HEADS * GLA_DK, GLA_HEADS * GLA_DV, GLA_HEADS * GLA_DV, 2 * GLA_RANK)
O_IN = sum(O_SIZES)

kernel_name = 'bidir_hybrid_rglru_deltanet_hgrn2_gla_moe'


def rmsnorm(x, g):
    xf = x.astype(jnp.float32)
    y = xf * lax.rsqrt(jnp.mean(jnp.square(xf), axis=-1, keepdims=True) + EPS)
    return (y * g.astype(jnp.float32)).astype(x.dtype)


def modulate(h, g, shift, scale):
    return rmsnorm(h, g) * (1.0 + scale) + shift


def split_cols(u, sizes):
    out, start = [], 0
    for s in sizes:
        out.append(u[..., start:start + s])
        start += s
    return out


def to_heads(t, n):
    b, l, _ = t.shape
    return t.reshape(b, l, n, -1).transpose(0, 2, 1, 3)


def from_heads(t):
    b, n, l, d = t.shape
    return t.transpose(0, 2, 1, 3).reshape(b, l, n * d)


def l2norm(t):
    return t * lax.rsqrt(jnp.sum(t * t, axis=-1, keepdims=True) + EPS)


def gated_rmsnorm(o, z, g):
    o = o * lax.rsqrt(jnp.mean(o * o, axis=-1, keepdims=True) + EPS) * g
    return o * jax.nn.silu(z)


def flip_seq(t, d, axis):
    return jnp.flip(t, axis=axis) if d == 1 else t


def dwconv_centred(x, w, b=None):
    k, ch = w.shape
    y = lax.conv_general_dilated(x, w[:, None, :].astype(x.dtype), (1,), [(k // 2, k - 1 - k // 2)],
                                 dimension_numbers=('NWC', 'WIO', 'NWC'), feature_group_count=ch)
    return y if b is None else y + b


def rglru_scan(u, gate_w, gate_b, lam, h0):
    b, l, w = u.shape
    gates = jnp.einsum('blhi,ghij->gblhj', u.reshape(b, l, RG_BLOCKS, RG_BLOCK), gate_w).reshape(2, b, l, w)
    gates = gates + gate_b[:, None, None, :]
    r, i = jax.nn.sigmoid(gates[0]), jax.nn.sigmoid(gates[1])
    log_a = -RG_C * r * jax.nn.softplus(-lam)
    a = jnp.exp(log_a)
    xin = jnp.sqrt(-jnp.expm1(2.0 * log_a)) * (i * u)
    xin = xin.at[:, 0].add(a[:, 0] * h0)

    def comb(left, right):
        return left[0] * right[0], right[0] * left[1] + right[1]

    return lax.associative_scan(comb, (a, xin), axis=1)[1]


def rglru_bidir(u_lat, u_ctx, gate_w, gate_b, lam):
    h0 = jnp.zeros((u_ctx.shape[0], u_ctx.shape[2]), jnp.float32)
    y_lat, y_ctx = 0.0, 0.0
    for d in range(2):
        hc = rglru_scan(flip_seq(u_ctx, d, 1), gate_w[d], gate_b[d], lam[d], h0)
        hl = rglru_scan(flip_seq(u_lat, d, 1), gate_w[d], gate_b[d], lam[d], hc[:, -1])
        y_ctx = y_ctx + flip_seq(hc, d, 1)
        y_lat = y_lat + flip_seq(hl, d, 1)
    return y_lat, y_ctx


def gated_delta_chunk(q, k, v, g, beta, s0):
    b, h, l, dk = k.shape
    dv = v.shape[-1]
    n = l // DN_CHUNK
    rs = lambda t: t.reshape(b, h, n, DN_CHUNK, *t.shape[3:])
    q, k, v, g, beta = rs(q), rs(k), rs(v), rs(g), rs(beta)
    gc = jnp.cumsum(g, axis=-1)
    incl = jnp.tril(jnp.ones((DN_CHUNK, DN_CHUNK), bool))
    strict = jnp.tril(jnp.ones((DN_CHUNK, DN_CHUNK), bool), -1)
    decay = jnp.exp(jnp.where(incl, gc[..., :, None] - gc[..., None, :], -jnp.inf))
    kb = k * beta[..., None]
    lower = jnp.where(strict, jnp.einsum('bhnid,bhnjd->bhnij', kb, k) * decay, 0.0)
    eye = jnp.eye(DN_CHUNK, dtype=k.dtype)
    rhs = jnp.concatenate([v * beta[..., None], kb * jnp.exp(gc)[..., None]], axis=-1)
    sol = lax.linalg.triangular_solve(eye + lower, rhs, left_side=True, lower=True, unit_diagonal=True)
    u, w = sol[..., :dv], sol[..., dv:]
    a_qk = jnp.einsum('bhnid,bhnjd->bhnij', q, k) * decay
    q_dec = q * jnp.exp(gc)[..., None]
    k_tail = k * jnp.exp(gc[..., -1:] - gc)[..., None]
    g_tot = jnp.exp(gc[..., -1])

    def step(s, xs):
        u_n, w_n, q_n, a_n, k_n, gt_n = xs
        v_new = u_n - jnp.einsum('bhck,bhkv->bhcv', w_n, s)
        o_n = jnp.einsum('bhck,bhkv->bhcv', q_n, s) + jnp.einsum('bhcj,bhjv->bhcv', a_n, v_new)
        s = s * gt_n[..., None, None] + jnp.einsum('bhck,bhcv->bhkv', k_n, v_new)
        return s, o_n

    xs = tuple(jnp.moveaxis(t, 2, 0) for t in (u, w, q_dec, a_qk, k_tail, g_tot))
    s_fin, o = lax.scan(step, s0, xs)
    return jnp.moveaxis(o, 0, 2).reshape(b, h, l, dv), s_fin


def gla_chunk(q, k, v, logd, s0):
    b, h, l, dk = k.shape
    dv = v.shape[-1]
    n = l // GLA_CHUNK
    rs = lambda t: t.reshape(b, h, n, GLA_CHUNK, t.shape[-1])
    q, k, v, logd = rs(q), rs(k), rs(v), rs(logd)
    bc = jnp.cumsum(logd, axis=-2)
    q_dec = q * jnp.exp(bc)
    incl = jnp.tril(jnp.ones((GLA_CHUNK, GLA_CHUNK), bool))
    a = jnp.where(incl, jnp.einsum('bhnid,bhnjd->bhnij', q_dec, k * jnp.exp(-bc)), 0.0)
    o_intra = jnp.einsum('bhnij,bhnjv->bhniv', a, v)
    k_tail = k * jnp.exp(bc[..., -1:, :] - bc)
    d_tot = jnp.exp(bc[..., -1, :])

    def step(s, xs):
        q_n, k_n, v_n, d_n = xs
        o_n = jnp.einsum('bhck,bhkv->bhcv', q_n, s)
        s = s * d_n[..., None] + jnp.einsum('bhck,bhcv->bhkv', k_n, v_n)
        return s, o_n

    xs = tuple(jnp.moveaxis(t, 2, 0) for t in (q_dec, k_tail, v, d_tot))
    s_fin, o_inter = lax.scan(step, s0, xs)
    o = o_intra + jnp.moveaxis(o_inter, 0, 2)
    return o.reshape(b, h, l, dv), s_fin


def gla_final_state(k, v, logd):
    bc = jnp.cumsum(logd, axis=2)
    return jnp.einsum('bhlk,bhlv->bhkv', k * jnp.exp(bc[:, :, -1:] - bc), v)


def bidir_scan(chunk_fn, state_fn, lat_in, ctx_in, s0, ctx_out):
    y_lat, y_ctx = 0.0, 0.0
    for d in range(2):
        c_args = [flip_seq(t, d, 2) for t in ctx_in[d]]
        if ctx_out:
            o_c, s_c = chunk_fn(*c_args, s0)
            y_ctx = y_ctx + flip_seq(o_c, d, 2)
        else:
            s_c = state_fn(*c_args)
        o_l, _ = chunk_fn(*[flip_seq(t, d, 2) for t in lat_in[d]], s_c)
        y_lat = y_lat + flip_seq(o_l, d, 2)
    return y_lat, (y_ctx if ctx_out else None)


def even_mixer(xl, xc, w_in, w_out, a_conv_w, a_conv_b, a_gate_w, a_gate_b, a_lambda,
               b_conv_w, b_a_log, b_dt_bias, b_norm_g, ctx_out):
    f32 = jnp.float32

    def prep(xs):
        bsz, l, _ = xs.shape
        ax, ay, qkv, z, bb, ba = split_cols(xs @ w_in, E_SIZES)
        ua = dwconv_centred(ax, a_conv_w, a_conv_b).astype(f32)
        qkv = jax.nn.silu(dwconv_centred(qkv, b_conv_w).astype(f32))
        q, k, v = split_cols(qkv, (DN_HEADS * DN_DK, DN_HEADS * DN_DK, DN_HEADS * DN_DV))
        q = l2norm(to_heads(q, DN_HEADS)) * DN_DK ** -0.5
        k = l2norm(to_heads(k, DN_HEADS))
        v = to_heads(v, DN_HEADS)
        beta = jax.nn.sigmoid(bb.astype(f32)).reshape(bsz, l, 2, DN_HEADS).transpose(2, 0, 3, 1)
        g = -jnp.exp(b_a_log.astype(f32)) * jax.nn.softplus(ba.astype(f32).reshape(bsz, l, 2, DN_HEADS) + b_dt_bias)
        g = g.transpose(2, 0, 3, 1)
        return ua, ay, [(q, k, v, g[d], beta[d]) for d in range(2)], z

    ua_l, ay_l, dn_l, z_l = prep(xl)
    ua_c, ay_c, dn_c, z_c = prep(xc)
    ha_l, ha_c = rglru_bidir(ua_l, ua_c, a_gate_w, a_gate_b, a_lambda)
    s0 = jnp.zeros((xc.shape[0], DN_HEADS, DN_DK, DN_DV), f32)
    ob_l, ob_c = bidir_scan(gated_delta_chunk, lambda *t: gated_delta_chunk(*t, s0)[1], dn_l, dn_c, s0, ctx_out)

    def merge(ha, ay, ob, z, dtype):
        ya = ha * jax.nn.gelu(ay.astype(f32))
        yb = from_heads(gated_rmsnorm(ob, to_heads(z.astype(f32), DN_HEADS), b_norm_g))
        return jnp.concatenate([ya, yb], axis=-1).astype(dtype) @ w_out

    y_l = merge(ha_l, ay_l, ob_l, z_l, xl.dtype)
    y_c = merge(ha_c, ay_c, ob_c, z_c, xc.dtype) if ctx_out else None
    return y_l, y_c


def odd_mixer(xl, xc, w_in, w_out, lb, c_norm_g, d_gate_w2, d_gate_b2, d_norm_g, ctx_out):
    f32 = jnp.float32
    lb = lb.astype(f32)

    def prep(xs):
        bsz, l, _ = xs.shape
        cq, cff, cfb, ci, cg, dq, dk, dv, dg, dlr = split_cols((xs @ w_in).astype(f32), O_SIZES)
        q_c = to_heads(jax.nn.silu(cq), HG_HEADS) * HG_DF ** -0.5
        v_c = to_heads(ci, HG_HEADS)
        hg_in = []
        for fl in (cff, cfb):
            log_f = jnp.log(lb + (1.0 - lb) * jax.nn.sigmoid(fl))
            k_c = (1.0 - lb) * jax.nn.sigmoid(-fl)
            hg_in.append((q_c, to_heads(k_c, HG_HEADS), v_c, to_heads(log_f, HG_HEADS)))
        q_d = to_heads(dq, GLA_HEADS) * GLA_DK ** -0.5
        k_d = to_heads(dk, GLA_HEADS)
        v_d = to_heads(dv, GLA_HEADS)
        lr = dlr.reshape(bsz, l, 2, GLA_RANK)
        logd = jax.nn.log_sigmoid(jnp.einsum('blgr,grk->gblk', lr, d_gate_w2) + d_gate_b2[:, None, None, :]) / GLA_GATE_NORM
        gla_in = [(q_d, k_d, v_d, to_heads(logd[d], GLA_HEADS)) for d in range(2)]
        return hg_in, gla_in, cg, dg

    hg_l, gl_l, cg_l, dg_l = prep(xl)
    hg_c, gl_c, cg_c, dg_c = prep(xc)
    state_fn = lambda q, k, v, logd: gla_final_state(k, v, logd)
    s0_c = jnp.zeros((xc.shape[0], HG_HEADS, HG_DF, HG_DI), f32)
    s0_d = jnp.zeros((xc.shape[0], GLA_HEADS, GLA_DK, GLA_DV), f32)
    yc_l, yc_c = bidir_scan(gla_chunk, state_fn, hg_l, hg_c, s0_c, ctx_out)
    yd_l, yd_c = bidir_scan(gla_chunk, state_fn, gl_l, gl_c, s0_d, ctx_out)

    def merge(yc, yd, cg, dg, dtype):
        oc = from_heads(gated_rmsnorm(yc, to_heads(cg, HG_HEADS), c_norm_g))
        od = from_heads(gated_rmsnorm(yd, to_heads(dg, GLA_HEADS), d_norm_g))
        return jnp.concatenate([oc, od], axis=-1).astype(dtype) @ w_out

    y_l = merge(yc_l, yd_l, cg_l, dg_l, xl.dtype)
    y_c = merge(yc_c, yd_c, cg_c, dg_c, xc.dtype) if ctx_out else None
    return y_l, y_c


def swiglu(xs, w_gate, w_up, w_down):
    return (jax.nn.silu(xs @ w_gate) * (xs @ w_up)) @ w_down


def moe_swiglu(xs, router_w, router_b, w_gate, w_up, w_down):
    logits = (xs @ router_w).astype(jnp.float32) + router_b.astype(jnp.float32)
    top_val, top_idx = lax.top_k(logits, TOP_K)
    top_p = jax.nn.softmax(top_val, axis=-1)
    gates = jnp.sum(jax.nn.one_hot(top_idx, N_EXPERTS, dtype=jnp.float32) * top_p[..., None], axis=-2).astype(xs.dtype)
    y = jnp.zeros_like(xs)
    for e in range(N_EXPERTS):
        y = y + gates[..., e:e + 1] * swiglu(xs, w_gate[e], w_up[e], w_down[e])
    return y


def setup_inputs(seed: int = 0) -> dict:
    key = jax.random.key(seed)
    keys = list(jax.random.split(key, 48))

    def nrm(shape, std=1.0):
        return std * jax.random.normal(keys.pop(), shape, jnp.float32)

    def unif(shape, lo, hi):
        return jax.random.uniform(keys.pop(), shape, jnp.float32, lo, hi)

    d = D_MODEL
    a_pow = unif((N_EVEN, 2, RG_WIDTH), 0.9, 0.999) ** (1.0 / RG_C)
    dt = jnp.exp(unif((N_EVEN, 2, DN_HEADS), float(np.log(1e-3)), float(np.log(1e-1))))
    a_log = jnp.log(unif((N_EVEN, 2, DN_HEADS), 1.0, 16.0))
    return {
        'x': nrm((BATCH, SEQ, d)),
        'c': nrm((BATCH, d)),
        'ctx': nrm((BATCH, CTX_LEN, d)),
        'c_ctx': nrm((d,)),
        'ada_w': nrm((DEPTH, d, 6 * d), 0.5 * d ** -0.5),
        'ada_b': nrm((DEPTH, 6 * d), 0.02),
        'norm_mix_g': 1.0 + nrm((DEPTH, d), 0.05),
        'norm_ffn_g': 1.0 + nrm((DEPTH, d), 0.05),
        'final_norm_g': 1.0 + nrm((d,), 0.05),
        'e_w_in': nrm((N_EVEN, d, E_IN), d ** -0.5),
        'e_w_out': nrm((N_EVEN, MIX_WIDTH, d), MIX_WIDTH ** -0.5),
        'e_a_conv_w': nrm((N_EVEN, CONV_K, RG_WIDTH), CONV_K ** -0.5),
        'e_a_conv_b': nrm((N_EVEN, RG_WIDTH), 0.02),
        'e_a_gate_w': nrm((N_EVEN, 2, 2, RG_BLOCKS, RG_BLOCK, RG_BLOCK), RG_BLOCK ** -0.5),
        'e_a_gate_b': nrm((N_EVEN, 2, 2, RG_WIDTH), 0.02),
        'e_a_lambda': jnp.log(a_pow) - jnp.log1p(-a_pow),
        'e_b_conv_w': nrm((N_EVEN, CONV_K, DN_HEADS * (2 * DN_DK + DN_DV)), CONV_K ** -0.5),
        'e_b_a_log': a_log,
        'e_b_dt_bias': dt + jnp.log(-jnp.expm1(-dt)),
        'e_b_norm_g': 1.0 + nrm((N_EVEN, DN_DV), 0.05),
        'e_ffn_w_gate': nrm((N_EVEN, d, D_FF), d ** -0.5),
        'e_ffn_w_up': nrm((N_EVEN, d, D_FF), d ** -0.5),
        'e_ffn_w_down': nrm((N_EVEN, D_FF, d), D_FF ** -0.5),
        'o_w_in': nrm((N_ODD, d, O_IN), d ** -0.5),
        'o_w_out': nrm((N_ODD, MIX_WIDTH, d), MIX_WIDTH ** -0.5),
        'o_lb_logits': nrm((DEPTH, HG_HEADS * HG_DF), 0.1),
        'o_c_norm_g': 1.0 + nrm((N_ODD, HG_DI), 0.05),
        'o_d_gate_w2': nrm((N_ODD, 2, GLA_RANK, GLA_HEADS * GLA_DK), GLA_RANK ** -0.5),
        'o_d_gate_b2': nrm((N_ODD, 2, GLA_HEADS * GLA_DK), 0.02),
        'o_d_norm_g': 1.0 + nrm((N_ODD, GLA_DV), 0.05),
        'o_router_w': nrm((N_ODD, d, N_EXPERTS), d ** -0.5),
        'o_router_b': nrm((N_ODD, N_EXPERTS), 0.01),
        'o_moe_w_gate': nrm((N_ODD, N_EXPERTS, d, D_EXPERT), d ** -0.5),
        'o_moe_w_up': nrm((N_ODD, N_EXPERTS, d, D_EXPERT), d ** -0.5),
        'o_moe_w_down': nrm((N_ODD, N_EXPERTS, D_EXPERT, d), D_EXPERT ** -0.5),
    }


def reference(x, c, ctx, c_ctx, ada_w, ada_b, norm_mix_g, norm_ffn_g, final_norm_g,
              e_w_in, e_w_out, e_a_conv_w, e_a_conv_b, e_a_gate_w, e_a_gate_b, e_a_lambda,
              e_b_conv_w, e_b_a_log, e_b_dt_bias, e_b_norm_g, e_ffn_w_gate, e_ffn_w_up, e_ffn_w_down,
              o_w_in, o_w_out, o_lb_logits, o_c_norm_g, o_d_gate_w2, o_d_gate_b2, o_d_norm_g,
              o_router_w, o_router_b, o_moe_w_gate, o_moe_w_up, o_moe_w_down):
    bsz, seq, dm = x.shape
    rows = seq // GRID_W
    lb_w = jax.nn.softmax(o_lb_logits.astype(jnp.float32), axis=0)
    lower_bounds = jnp.cumsum(lb_w, axis=0) - lb_w[0]
    s_lat = jax.nn.silu(c)
    s_ctx = jax.nn.silu(c_ctx)
    h_lat, h_ctx = x, ctx
    for l in range(DEPTH):
        j = l // 2
        ctx_out = l < DEPTH - 1
        ml = jnp.split((s_lat @ ada_w[l] + ada_b[l])[:, None, :], 6, axis=-1)
        mc = jnp.split(s_ctx @ ada_w[l] + ada_b[l], 6, axis=-1)
        xl = modulate(h_lat, norm_mix_g[l], ml[0], ml[1])
        xc = modulate(h_ctx, norm_mix_g[l], mc[0], mc[1])
        if l % 2 == 0:
            yl, yc = even_mixer(xl, xc, e_w_in[j], e_w_out[j], e_a_conv_w[j], e_a_conv_b[j], e_a_gate_w[j],
                                e_a_gate_b[j], e_a_lambda[j], e_b_conv_w[j], e_b_a_log[j], e_b_dt_bias[j],
                                e_b_norm_g[j], ctx_out)
        else:
            xl_cm = xl.reshape(bsz, rows, GRID_W, dm).swapaxes(1, 2).reshape(bsz, seq, dm)
            yl_cm, yc = odd_mixer(xl_cm, xc, o_w_in[j], o_w_out[j], lower_bounds[l], o_c_norm_g[j],
                                  o_d_gate_w2[j], o_d_gate_b2[j], o_d_norm_g[j], ctx_out)
            yl = yl_cm.reshape(bsz, GRID_W, rows, dm).swapaxes(1, 2).reshape(bsz, seq, dm)
        h_lat = h_lat + ml[2] * yl

        def channel_mixer(xs):
            if l % 2 == 0:
                return swiglu(xs, e_ffn_w_gate[j], e_ffn_w_up[j], e_ffn_w_down[j])
            return moe_swiglu(xs, o_router_w[j], o_router_b[j], o_moe_w_gate[j], o_moe_w_up[j], o_moe_w_down[j])

        h_lat = h_lat + ml[5] * channel_mixer(modulate(h_lat, norm_ffn_g[l], ml[3], ml[4]))
        if ctx_out:
            h_ctx = h_ctx + mc[2] * yc
            h_ctx = h_ctx + mc[5] * channel_mixer(modulate(h_ctx, norm_ffn_g[l], mc[3], mc[4]))
    return rmsnorm(h_lat, final_norm_g)
```

```cpp
#define MK_SINGLE 1
#include <hip/hip_runtime.h>
#include <cstdio>
#include <cstdint>

__device__ __forceinline__ int tid_fresh() { int t = threadIdx.x; asm volatile("" : "+v"(t)); return t; }
namespace pg8 {
#define PG8_LAS __attribute__((address_space(3)))
typedef unsigned short bf16_t;
typedef short bf16x8 __attribute__((ext_vector_type(8)));
typedef float f32x4 __attribute__((ext_vector_type(4)));
typedef unsigned u32x4 __attribute__((ext_vector_type(4)));
constexpr int BM = 256, BK = 64, HALF = 128, HTB = HALF * BK * 2  , STAGE_BYTES = 8 * HTB, NXCD = 8, WGM = 8;

__host__ __device__ __forceinline__ int lds_byte(int r, int c) { const int st = (r >> 4) * 2 + (c >> 5), rr = r & 15, cc = c & 31, ob = rr * 64 + cc * 2; return st * 1024 + (ob ^ (((ob >> 9) & 1) << 5)); }
__host__ __device__ __forceinline__ void stage_rc(int b, int& R, int& C) { const int st = b / 1024, sb = b % 1024, swz = sb ^ (((sb >> 9) & 1) << 5); R = (st >> 1) * 16 + swz / 64; C = (st & 1) * 32 + (swz % 64) / 2; }
__host__ __device__ __forceinline__ int perm32(int rho) { const int n = rho >> 4, i = rho & 15; return 8 * (i >> 2) + 4 * n + (i & 3); }

struct Unit { int pm, pn, pb, ko, nkt, split; };
struct Gemm { const bf16_t* A; const bf16_t* Bt; int K; };

__host__ __device__ __forceinline__ int tail_slices(int R, int G, int kt) { if (R <= 0 || kt != 44) return 1; const int q = G / R; return q >= 8 ? 8 : (q >= 4 ? 4 : (q >= 2 ? 2 : 1)); }
__host__ __device__ __forceinline__ void tail_slice(int S, int s, int kt, int& ko, int& nkt) {
    if (S == 8) { nkt = s < 6 ? 6 : 4; ko = 64 * (s < 6 ? 6 * s : 36 + 4 * (s - 6)); }
    else if (S == 4 && kt == 16) { nkt = 4; ko = 256 * s; }
    else if (S == 4) { nkt = s < 2 ? 12 : 10; ko = 64 * (s < 2 ? 12 * s : 24 + 10 * (s - 2)); }
    else if (S == 2) { nkt = 22; ko = 64 * 22 * s; }
    else { nkt = kt; ko = 0; }
}
struct StaticOrder {
    int nM, nN, nwg, G, c, kt, F, S;
    __host__ __device__ __forceinline__ void init(int M, int N, int G_, int c_, int K = 1024, bool split_tail = false) { nM = M / BM; nN = N / BM; nwg = nM * nN; G = G_; c = c_; kt = K / BK;
        F = (nwg / G) * G; S = split_tail ? tail_slices(nwg - F, G, kt) : 1; if (S == 1) F = nwg; }
    __host__ __device__ __forceinline__ bool next(int i, Unit& u) const {
        long L = (long)i * G + c; u.ko = 0; u.nkt = kt; u.split = 0;
        if (L >= F) { const long t = L - F; if (t >= (long)(nwg - F) * S) return false; const int s = (int)(t % S); L = F + t / S; tail_slice(S, s, kt, u.ko, u.nkt); u.split = 1; }
        int wgid = (int)L; { const int q = nwg / NXCD, r = nwg % NXCD, xcd = wgid % NXCD, off = wgid / NXCD; wgid = (xcd < r ? xcd * (q + 1) : r * (q + 1) + (xcd - r) * q) + off; }
        const int nig = WGM * nN, gid = wgid / nig, fm = gid * WGM, gsz = (nM - fm) < WGM ? (nM - fm) : WGM;
        u.pm = fm + ((wgid % nig) % gsz); u.pn = (wgid % nig) / gsz; u.pb = u.pn; return true;
    }
    __device__ __forceinline__ void a_ready(const Unit&) const {}
    __device__ __forceinline__ void done(const Unit&) const {}
};
template <int KT, int S> struct CtxSplitOrder {
    int G, c;
    __device__ __forceinline__ bool next(int i, Unit& u) const {
        const int L = i * G + c; u.ko = 0; u.nkt = KT; u.split = 0;
        if (L < 256) { u.pm = L >> 2; u.pn = L & 3; u.pb = u.pn; return true; }
        const int t = L - 256; if (t >= 32 * S) return false;
        const int cu = t / S, s = t - cu * S; u.pm = 64 + (cu >> 2); u.pn = cu & 3; u.pb = u.pn; tail_slice(S, s, KT, u.ko, u.nkt); u.split = s + 1; return true;
    }
    __device__ __forceinline__ void a_ready(const Unit&) const {}
    __device__ __forceinline__ void done(const Unit&) const {}
};
struct GroupOrder {
    const int* tile_e; int ntiles, npn, G, c, kt, F, S;
    __device__ __forceinline__ bool next(int i, Unit& u) const {
        int L = i * G + c; u.ko = 0; u.nkt = kt; u.split = 0;
        if (L >= F) { const int t = L - F; if (t >= (ntiles * npn - F) * S) return false; const int s = t % S; L = F + t / S; if (S > 1) { tail_slice(S, s, kt, u.ko, u.nkt); u.split = s + 1; } }
        if (npn == 22) {
            const int sr = L / 176, r = L - sr * 176, rem = ntiles - 8 * sr, tq = rem < 8 ? rem : 8, r2 = rem < 8 ? L - sr * 176 : r;
            const int blk = r2 / (4 * tq), w = r2 - blk * 4 * tq; u.pm = sr * 8 + w % tq; u.pn = blk * 4 + w / tq;
        } else { u.pm = L / npn; u.pn = L - u.pm * npn; } u.pb = __hip_atomic_load(tile_e + u.pm, __ATOMIC_RELAXED, __HIP_MEMORY_SCOPE_AGENT) * npn + u.pn; return true;
    }
    __device__ __forceinline__ void a_ready(const Unit&) const {}
    __device__ __forceinline__ void done(const Unit&) const {}
};

__host__ __device__ __forceinline__ float* moe_part_base(unsigned char* wsb, int s, int S) {
    const size_t MiB_ = 1u << 20, sz = (S == 8 ? 8 : 16) * MiB_; const int nhi = S == 8 ? 6 : 3;
    return (float*)(wsb + (s < nhi ? 389 * MiB_ + (size_t)s * sz : 182 * MiB_ + (size_t)(s - nhi) * sz));
}
typedef float f32x2_e __attribute__((ext_vector_type(2)));
typedef __bf16 bf16x2_e __attribute__((ext_vector_type(2)));
__device__ __forceinline__ unsigned cvt_pk_bf16(float lo, float hi) { const f32x2_e v = {lo, hi}; return __builtin_bit_cast(unsigned, __builtin_convertvector(v, bf16x2_e)); }

struct EpiBf16 {
    static constexpr bool PERM = true, AFTER_DRAIN = false;
    bf16_t* O; int ldc;
    __device__ __forceinline__ void operator()(const f32x4 (&acc)[2][2][4][2], const Unit& u, int wr, int wc, int fr, int fq) const {
        const int row0 = u.pm * BM + wr * 64 + fr, col0 = u.pn * BM + wc * 32 + 8 * fq;
#pragma unroll
        for (int ai = 0; ai < 2; ++ai)
#pragma unroll
            for (int m = 0; m < 4; ++m) { bf16_t* rowp = O + (size_t)(row0 + ai * HALF + m * 16) * ldc + col0;
#pragma unroll
                for (int bj = 0; bj < 2; ++bj) { const f32x4 v0 = acc[ai][bj][m][0], v1 = acc[ai][bj][m][1];
                    u32x4 w; w.x = cvt_pk_bf16(v0[0], v0[1]); w.y = cvt_pk_bf16(v0[2], v0[3]); w.z = cvt_pk_bf16(v1[0], v1[1]); w.w = cvt_pk_bf16(v1[2], v1[3]);
                    *(u32x4*)(rowp + bj * HALF) = w; } }
    }
};
struct EpiSwiGLU {
    static constexpr bool PERM = true, AFTER_DRAIN = false;
    bf16_t* O; int ldc;
    __device__ __forceinline__ void operator()(const f32x4 (&acc)[2][2][4][2], const Unit& u, int wr, int wc, int fr, int fq) const {
        const int row0 = u.pm * BM + wr * 64 + fr, col0 = u.pn * HALF + wc * 32 + 8 * fq;
#pragma unroll
        for (int ai = 0; ai < 2; ++ai)
#pragma unroll
            for (int m = 0; m < 4; ++m) { bf16_t* rowp = O + (size_t)(row0 + ai * HALF + m * 16) * ldc + col0;
                float r[8];
#pragma unroll
                for (int n = 0; n < 2; ++n)
#pragma unroll
                    for (int j = 0; j < 4; ++j) { const float g = acc[ai][0][m][n][j], up = acc[ai][1][m][n][j]; r[n * 4 + j] = g * up * __builtin_amdgcn_rcpf(1.0f + __expf(-g)); }
                u32x4 w; w.x = cvt_pk_bf16(r[0], r[1]); w.y = cvt_pk_bf16(r[2], r[3]); w.z = cvt_pk_bf16(r[4], r[5]); w.w = cvt_pk_bf16(r[6], r[7]);
                *(u32x4*)rowp = w; }
    }
};
template <int MODE> struct EpiResid {
    static constexpr bool PERM = false, AFTER_DRAIN = false;
    const float* base_lat; float* out_lat; const float* base_ctx; float* out_ctx; const float* gate;
    float* part;
    __device__ __forceinline__ void operator()(const f32x4 (&acc)[2][2][4][2], const Unit& u, int wr, int wc, int fr, int fq) const {
        const int row0 = u.pm * BM + wr * 64 + fr, col0 = u.pn * BM + wc * 32 + 4 * fq;
        const int sg = MODE == 0 ? (u.pm < 64 ? (u.pm >> 3) : 8) : (u.pm >> 3);
        f32x4 g[2][2];
#pragma unroll
        for (int bj = 0; bj < 2; ++bj)
#pragma unroll
            for (int n = 0; n < 2; ++n) g[bj][n] = *(const f32x4*)(gate + sg * 6144 + col0 + bj * HALF + n * 16);
#pragma unroll
        for (int ai = 0; ai < 2; ++ai) {
            const float* bp[4]; float* op[4];
#pragma unroll
            for (int m = 0; m < 4; ++m) { const int r = row0 + ai * HALF + m * 16;
                if (MODE == 0) { if (r < 16384) { bp[m] = base_lat + (size_t)r * 1024; op[m] = out_lat + (size_t)r * 1024; } else { bp[m] = base_ctx + (size_t)(r - 16384) * 1024; op[m] = out_ctx + (size_t)(r - 16384) * 1024; } }
                else { const int p = r & 2047, tok = (r & ~2047) + (p & 31) * 64 + (p >> 5); bp[m] = base_lat + (size_t)tok * 1024; op[m] = out_lat + (size_t)tok * 1024; } }
            if (MODE == 0 && u.split) {
#pragma unroll
                for (int m = 0; m < 4; ++m) { const int r = row0 + ai * HALF + m * 16;
#pragma unroll
                    for (int bj = 0; bj < 2; ++bj)
#pragma unroll
                        for (int n = 0; n < 2; ++n) *(f32x4*)(part + ((size_t)(u.split - 1) * 2048 + (r - 16384)) * 1024 + col0 + bj * HALF + n * 16) = g[bj][n] * acc[ai][bj][m][n]; }
            } else {
                f32x4 b[4][2][2];
#pragma unroll
                for (int m = 0; m < 4; ++m)
#pragma unroll
                    for (int bj = 0; bj < 2; ++bj)
#pragma unroll
                        for (int n = 0; n < 2; ++n) b[m][bj][n] = *(const f32x4*)(bp[m] + col0 + bj * HALF + n * 16);
#pragma unroll
                for (int m = 0; m < 4; ++m)
#pragma unroll
                    for (int bj = 0; bj < 2; ++bj)
#pragma unroll
                        for (int n = 0; n < 2; ++n) *(f32x4*)(op[m] + col0 + bj * HALF + n * 16) = b[m][bj][n] + g[bj][n] * acc[ai][bj][m][n];
            }
        }
    }
};
struct EpiF32 {
    static constexpr bool PERM = false, AFTER_DRAIN = false;
    bf16_t* C; int ldc; unsigned char* wsb; int tail_row0, S;
    __device__ __forceinline__ void operator()(const f32x4 (&acc)[2][2][4][2], const Unit& u, int wr, int wc, int fr, int fq) const {
        const int row0 = u.pm * BM + wr * 64 + fr, col0 = u.pn * BM + wc * 32 + 4 * fq;
#pragma unroll
        for (int ai = 0; ai < 2; ++ai)
#pragma unroll
            for (int m = 0; m < 4; ++m) { const int r = row0 + ai * HALF + m * 16;
                if (u.split) { float* rowp = moe_part_base(wsb, u.split - 1, S) + (size_t)(r - tail_row0) * ldc + col0;
#pragma unroll
                    for (int bj = 0; bj < 2; ++bj)
#pragma unroll
                        for (int n = 0; n < 2; ++n) *(f32x4*)(rowp + bj * HALF + n * 16) = acc[ai][bj][m][n]; }
                else { bf16_t* rowp = C + (size_t)r * ldc + col0;
#pragma unroll
                    for (int bj = 0; bj < 2; ++bj)
#pragma unroll
                        for (int n = 0; n < 2; ++n) { const f32x4 v = acc[ai][bj][m][n]; typedef unsigned u32x2_ __attribute__((ext_vector_type(2))); u32x2_ w; w.x = cvt_pk_bf16(v[0], v[1]); w.y = cvt_pk_bf16(v[2], v[3]); *(u32x2_*)(rowp + bj * HALF + n * 16) = w; } } }
    }
};


template <class Epi, class Sched, bool ALIGN_EPI = false, bool SP2 = false>
__device__ __forceinline__ void gemm_phase(PG8_LAS unsigned char* lds, const Gemm g, const Sched& S, const Epi& E) {
    const int tid = tid_fresh(), wid = __builtin_amdgcn_readfirstlane(tid >> 6), lane = tid & 63, wr = wid >> 2, wc = wid & 3, fr = lane & 15, fq = lane >> 4;
    const int K = g.K;
    unsigned voffA[2], voffB[2];
#pragma unroll
    for (int i = 0; i < 2; ++i) { int R, C; stage_rc(tid * 16 + i * 8192, R, C); const int Rb = Epi::PERM ? ((R & ~31) + perm32(R & 31)) : R;
        voffA[i] = (unsigned)(R * K + C) * 2u; voffB[i] = (unsigned)(Rb * K + C) * 2u; }
    const size_t kstep = (size_t)(BK * 2);
    const size_t hstep = (size_t)HALF * K * 2;
    const size_t tstep = 2 * hstep;
    const unsigned ldsw = (unsigned)wid * 1024u;
    const int aoff = lds_byte(wr * 64 + fr, fq * 8), boff = lds_byte(wc * 32 + fr, fq * 8);
#define PG8_SA(b, h) (((b) * 2 + (h)) * HTB)
#define PG8_SB(b, h) ((4 + (b) * 2 + (h)) * HTB)
#define PG8_STAGE(bufoff, gbase, voff) do { _Pragma("unroll") for (int _i = 0; _i < 2; ++_i) \
        __builtin_amdgcn_global_load_lds((const unsigned*)((const char*)(gbase) + (voff)[_i]), (PG8_LAS unsigned*)(lds + (bufoff) + ldsw + _i * 8192), 16, 0, 0); } while (0)
#define PG8_LDA(dst, b, h) do { _Pragma("unroll") for (int m = 0; m < 4; ++m) _Pragma("unroll") for (int k = 0; k < 2; ++k) dst[m][k] = *(const PG8_LAS bf16x8*)(lds + PG8_SA(b, h) + aoff + m * 2048 + k * 1024); } while (0)
#define PG8_LDB(dst, b, h) do { _Pragma("unroll") for (int n = 0; n < 2; ++n) _Pragma("unroll") for (int k = 0; k < 2; ++k) dst[n][k] = *(const PG8_LAS bf16x8*)(lds + PG8_SB(b, h) + boff + n * 2048 + k * 1024); } while (0)
#define PG8_MMA(ai, bj, At, Bt) do { __builtin_amdgcn_s_setprio(1); _Pragma("unroll") for (int m = 0; m < 4; ++m) _Pragma("unroll") for (int n = 0; n < 2; ++n) _Pragma("unroll") for (int k = 0; k < 2; ++k) \
        acc[ai][bj][m][n] = __builtin_amdgcn_mfma_f32_16x16x32_bf16(Bt[n][k], At[m][k], acc[ai][bj][m][n], 0, 0, 0); __builtin_amdgcn_s_setprio(0); } while (0)
#define PG8_WAIT_V(n) asm volatile("s_waitcnt vmcnt(" #n ")" ::: "memory")
#define PG8_WAIT_L(n) asm volatile("s_waitcnt lgkmcnt(" #n ")" ::: "memory")
#define PG8_BAR __builtin_amdgcn_s_barrier()
#define PG8_SCHED __builtin_amdgcn_sched_barrier(0)
    Unit cur, nxt; int ui = 0;
    if (!S.next(0, cur)) return;
    f32x4 acc[2][2][4][2];
#pragma unroll
    for (int a = 0; a < 2; ++a)
#pragma unroll
        for (int b = 0; b < 2; ++b)
#pragma unroll
            for (int m = 0; m < 4; ++m)
#pragma unroll
                for (int n = 0; n < 2; ++n) acc[a][b][m][n] = (f32x4){0.f, 0.f, 0.f, 0.f};
    bf16x8 At[4][2], B0[2][2], B1[2][2];
    const char* cA = (const char*)g.A + (size_t)cur.pm * tstep + (size_t)cur.ko * 2; const char* cB = (const char*)g.Bt + (size_t)cur.pb * tstep + (size_t)cur.ko * 2; int nt = cur.nkt;
    S.a_ready(cur);
    if constexpr (SP2) {
        PG8_STAGE(PG8_SB(0, 0), cB, voffB); PG8_STAGE(PG8_SB(0, 1), cB + hstep, voffB); PG8_STAGE(PG8_SA(0, 0), cA, voffA); PG8_STAGE(PG8_SA(0, 1), cA + hstep, voffA);
        if (wr == 1) PG8_BAR;
        PG8_WAIT_V(2); PG8_BAR;
        PG8_STAGE(PG8_SB(1, 0), cB + kstep, voffB); PG8_STAGE(PG8_SA(1, 0), cA + kstep, voffA); PG8_STAGE(PG8_SB(1, 1), cB + hstep + kstep, voffB);
        PG8_WAIT_V(6); PG8_BAR;
    } else {
        PG8_STAGE(PG8_SB(0, 0), cB, voffB); PG8_STAGE(PG8_SA(0, 0), cA, voffA); PG8_STAGE(PG8_SB(0, 1), cB + hstep, voffB); PG8_STAGE(PG8_SA(0, 1), cA + hstep, voffA);
        if (wr == 1) PG8_BAR;
        PG8_WAIT_V(4); PG8_BAR;
        PG8_STAGE(PG8_SB(1, 0), cB + kstep, voffB); PG8_STAGE(PG8_SA(1, 0), cA + kstep, voffA); PG8_STAGE(PG8_SB(1, 1), cB + hstep + kstep, voffB);
        PG8_WAIT_V(6); PG8_BAR;
    }
    for (;;) {
        const bool has_next = S.next(ui + 1, nxt);
        const char* nA = has_next ? (const char*)g.A + (size_t)nxt.pm * tstep + (size_t)nxt.ko * 2 : cA; const char* nB = has_next ? (const char*)g.Bt + (size_t)nxt.pb * tstep + (size_t)nxt.ko * 2 : cB;
        for (int t = 0; t < nt; t += 2) {
            const bool last = (t == nt - 2);
            const char* a1 = cA + (size_t)(t + 1) * kstep;
            const char* a2 = last ? nA : cA + (size_t)(t + 2) * kstep; const char* b2 = last ? nB : cB + (size_t)(t + 2) * kstep;
            const char* a3 = a2 + kstep; const char* b3 = b2 + kstep;
            if (last && has_next) S.a_ready(nxt);
            if constexpr (SP2) {
            PG8_LDB(B0, 0, 0); PG8_LDB(B1, 0, 1); PG8_SCHED; PG8_LDA(At, 0, 0); PG8_STAGE(PG8_SA(1, 1), a1 + hstep, voffA);
            PG8_WAIT_V(8); PG8_WAIT_L(0); PG8_BAR; PG8_MMA(0, 0, At, B0); PG8_MMA(0, 1, At, B1); PG8_BAR; PG8_SCHED;
            PG8_LDA(At, 0, 1); PG8_STAGE(PG8_SB(0, 0), b2, voffB); PG8_STAGE(PG8_SB(0, 1), b2 + hstep, voffB); PG8_STAGE(PG8_SA(0, 0), a2, voffA);
            PG8_WAIT_V(8); PG8_WAIT_L(0); PG8_BAR; PG8_MMA(1, 0, At, B0); PG8_MMA(1, 1, At, B1); PG8_BAR; PG8_SCHED;
            PG8_LDB(B0, 1, 0); PG8_LDB(B1, 1, 1); PG8_SCHED; PG8_LDA(At, 1, 0); PG8_STAGE(PG8_SA(0, 1), a2 + hstep, voffA);
            PG8_WAIT_V(8); PG8_WAIT_L(0); PG8_BAR; PG8_MMA(0, 0, At, B0); PG8_MMA(0, 1, At, B1); PG8_BAR; PG8_SCHED;
            PG8_LDA(At, 1, 1); PG8_STAGE(PG8_SB(1, 0), b3, voffB); PG8_STAGE(PG8_SB(1, 1), b3 + hstep, voffB); PG8_STAGE(PG8_SA(1, 0), a3, voffA);
            PG8_WAIT_V(8); PG8_WAIT_L(0); PG8_BAR; PG8_MMA(1, 0, At, B0); PG8_MMA(1, 1, At, B1); PG8_BAR; PG8_SCHED;
            } else {
            PG8_LDB(B0, 0, 0); PG8_SCHED; PG8_LDA(At, 0, 0); PG8_STAGE(PG8_SA(1, 1), a1 + hstep, voffA);
            PG8_WAIT_L(8); PG8_BAR; PG8_WAIT_L(0); PG8_MMA(0, 0, At, B0); PG8_BAR; PG8_SCHED;
            PG8_LDB(B1, 0, 1); PG8_STAGE(PG8_SB(0, 0), b2, voffB);
            PG8_BAR; PG8_WAIT_L(0); PG8_MMA(0, 1, At, B1); PG8_BAR;
            PG8_LDA(At, 0, 1); PG8_STAGE(PG8_SA(0, 0), a2, voffA);
            PG8_BAR; PG8_WAIT_L(0); PG8_MMA(1, 0, At, B0); PG8_BAR; PG8_SCHED;
            PG8_STAGE(PG8_SB(0, 1), b2 + hstep, voffB);
            PG8_WAIT_V(6); PG8_BAR; PG8_MMA(1, 1, At, B1); PG8_BAR;
            PG8_LDB(B0, 1, 0); PG8_SCHED; PG8_LDA(At, 1, 0); PG8_STAGE(PG8_SA(0, 1), a2 + hstep, voffA);
            PG8_WAIT_L(8); PG8_BAR; PG8_WAIT_L(0); PG8_MMA(0, 0, At, B0); PG8_BAR; PG8_SCHED;
            PG8_LDB(B1, 1, 1); PG8_STAGE(PG8_SB(1, 0), b3, voffB);
            PG8_BAR; PG8_WAIT_L(0); PG8_MMA(0, 1, At, B1); PG8_BAR;
            PG8_LDA(At, 1, 1); PG8_STAGE(PG8_SA(1, 0), a3, voffA);
            PG8_BAR; PG8_WAIT_L(0); PG8_MMA(1, 0, At, B0); PG8_BAR; PG8_SCHED;
            PG8_STAGE(PG8_SB(1, 1), b3 + hstep, voffB);
            PG8_WAIT_V(6); PG8_BAR; PG8_MMA(1, 1, At, B1); PG8_BAR;
            }
        }
        if constexpr (ALIGN_EPI) { if (wr == 0) PG8_BAR; }
        if constexpr (!Epi::AFTER_DRAIN) { E(acc, cur, wr, wc, fr, fq); S.done(cur); }
        if (!has_next) break;
#pragma unroll
        for (int a = 0; a < 2; ++a)
#pragma unroll
            for (int b = 0; b < 2; ++b)
#pragma unroll
                for (int m = 0; m < 4; ++m)
#pragma unroll
                    for (int n = 0; n < 2; ++n) acc[a][b][m][n] = (f32x4){0.f, 0.f, 0.f, 0.f};
        cur = nxt; cA = nA; cB = nB; nt = cur.nkt; ++ui;
        if constexpr (ALIGN_EPI) { if (wr == 1) PG8_BAR; }
    }
    PG8_WAIT_V(0);
    if constexpr (!ALIGN_EPI) { if (wr == 0) PG8_BAR; }
    PG8_BAR;
    if constexpr (Epi::AFTER_DRAIN) { E.fused(acc, cur, wr, wc, fr, fq, lds, wid, lane); S.done(cur); }
#undef PG8_SA
#undef PG8_SB
#undef PG8_STAGE
#undef PG8_LDA
#undef PG8_LDB
#undef PG8_MMA
#undef PG8_WAIT_V
#undef PG8_WAIT_L
#undef PG8_BAR
#undef PG8_SCHED
}
}

constexpr int NWAVES = 8, NT = 512;
constexpr int D = 1024, NB = 8, SEQ = 2048, CTXL = 256, ML = NB * SEQ, MC = NB * CTXL, M0 = ML + MC;
constexpr int E_IN = 3088, O_IN = 4128, DFF = 2816, NEXP = 8, NU0 = 3072, NU1 = 4096;
constexpr int NU0S = 3328, NU1S = 4352;
constexpr float EPS = 1e-6f;
constexpr int MPAD = 2 * ML + NEXP * 256;

enum { I_X = 0, I_C, I_CTX, I_CCTX, I_ADAW, I_ADAB, I_NMIX, I_NFFN, I_FINALG, I_EWIN, I_EWOUT, I_ACONVW, I_ACONVB, I_AGATEW, I_AGATEB, I_ALAM,
       I_BCONVW, I_BALOG, I_BDT, I_BNORMG, I_EFG, I_EFU, I_EFD, I_OWIN, I_OWOUT, I_LBLOG, I_CNORMG, I_DGW2, I_DGB2, I_DNORMG, I_RW, I_RB, I_MG, I_MU, I_MD, N_IN };

constexpr size_t MiB = 1u << 20;
constexpr size_t WS_CTL = 0, CTL_ZERO_BYTES = 1 * MiB;
constexpr size_t WS_MOD = 1 * MiB;
constexpr size_t WS_TOPK = 1 * MiB + 512 * 1024;
constexpr size_t WS_WIN0 = 2 * MiB, WS_WOUT0 = 9 * MiB, WS_WGU0 = 11 * MiB, WS_WDN0 = 22 * MiB, WS_WIN1 = 28 * MiB, WS_WOUT1 = 37 * MiB;
constexpr size_t WS_GS = 37 * MiB;
constexpr size_t WS_HCTX = 40 * MiB;
constexpr size_t WS_XN = 48 * MiB;
constexpr size_t WS_Y = 84 * MiB;
constexpr size_t WS_U = 120 * MiB;
constexpr size_t WS_DNQ = 273 * MiB, WS_DNK = 291 * MiB, WS_DNV = 309 * MiB;
constexpr size_t WS_DNO = 327 * MiB;
constexpr size_t WS_RGH = 354 * MiB;
constexpr size_t WS_O1 = 273 * MiB;
constexpr size_t WS_WDN1 = 2 * MiB, WS_WGU1 = 46 * MiB, WS_XS = 134 * MiB, WS_ACTS = 202 * MiB, WS_XN2 = 389 * MiB, WS_OUTS = 46 * MiB;
constexpr size_t WS_QDH = 337 * MiB, WS_QDG = 369 * MiB, WS_KTH = 385 * MiB, WS_KTG = 421 * MiB, WS_A1 = 48 * MiB, WS_DT1 = 40 * MiB;
constexpr size_t WS_DNT = 48 * MiB, WS_DNA = 66 * MiB, WS_DNVEC = 40 * MiB;
constexpr size_t WS_GWT = 39 * MiB + 512 * 1024, WS_RGSUM = 43 * MiB;
constexpr size_t WS_RGCARRY = 435 * MiB, WS_RGAX = 363 * MiB;
constexpr size_t WS_PART0 = 273 * MiB;
constexpr size_t WS_END = 440 * MiB;
constexpr int CW_TMO = 0, CW_CNT = 64  , CW_NTILES = 640, CW_TAILF = 641, CW_TAILS = 642, CW_TILE_E = 704, CW_BAR = 4096;

#define GAS __attribute__((address_space(1)))
#define LAS __attribute__((address_space(3)))
#define DI __device__ __forceinline__
typedef unsigned short bf16;
typedef unsigned v4u __attribute__((ext_vector_type(4)));
typedef unsigned v2u __attribute__((ext_vector_type(2)));
typedef float f32x4 __attribute__((ext_vector_type(4)));
typedef short bf16x8 __attribute__((ext_vector_type(8)));
typedef GAS unsigned gu32;
#define RLX_AGENT __ATOMIC_RELAXED, __HIP_MEMORY_SCOPE_AGENT
#define LDS_WAIT() asm volatile("s_waitcnt lgkmcnt(0)" ::: "memory")
#define LDS_BARRIER() do { asm volatile("s_waitcnt lgkmcnt(0)" ::: "memory"); __builtin_amdgcn_s_barrier(); asm volatile("" ::: "memory"); } while (0)
typedef float f32x2_t __attribute__((ext_vector_type(2)));
typedef __bf16 bf16x2_t __attribute__((ext_vector_type(2)));
DI unsigned pk2(float lo, float hi) { const f32x2_t v = {lo, hi}; return __builtin_bit_cast(unsigned, __builtin_convertvector(v, bf16x2_t)); }
DI unsigned f2bf(float f) { return pk2(f, 0.0f) & 0xffffu; }
DI float bflo(unsigned u) { return __builtin_bit_cast(float, u << 16); }
DI float bfhi(unsigned u) { return __builtin_bit_cast(float, u & 0xffff0000u); }
DI float bf2f(bf16 b) { return __builtin_bit_cast(float, (unsigned)b << 16); }
DI float frcp(float x) { return __builtin_amdgcn_rcpf(x); }
DI float sigm(float x) { return frcp(1.0f + __expf(-x)); }
DI float silu_(float x) { return x * sigm(x); }
DI float softplus_(float x) { return fmaxf(x, 0.f) + log1pf(expf(-fabsf(x))); }
DI float softplus_fast(float x) { return fmaxf(x, 0.f) + __logf(1.0f + __expf(-fabsf(x))); }
DI float gelu_tanh(float x) { return x * sigm(1.5957691216057308f * (x + 0.044715f * x * x * x)); }
template <int CTRL> DI float dpp_mov(float v) { return __builtin_bit_cast(float, __builtin_amdgcn_update_dpp(0, __builtin_bit_cast(int, v), CTRL, 0xF, 0xF, false)); }
DI float sum4(float v) { v += dpp_mov<0xB1>(v); v += dpp_mov<0x4E>(v); return v; }
DI float sum8(float v) { v = sum4(v); v += dpp_mov<0x141>(v); return v; }
DI float sum16(float v) { v = sum8(v); v += dpp_mov<0x140>(v); return v; }
DI float wave_sum(float v) {
    v = sum16(v);
    const int iv = __builtin_bit_cast(int, v);
    return (__builtin_bit_cast(float, __builtin_amdgcn_readlane(iv, 0)) + __builtin_bit_cast(float, __builtin_amdgcn_readlane(iv, 16))) + (__builtin_bit_cast(float, __builtin_amdgcn_readlane(iv, 32)) + __builtin_bit_cast(float, __builtin_amdgcn_readlane(iv, 48)));
}
DI int rowmap(int b, int d, int p) { return p < CTXL ? ML + b * CTXL + (d ? CTXL - 1 - p : p) : b * SEQ + (d ? SEQ - 1 - (p - CTXL) : (p - CTXL)); }

#define XB_TMO      128
#define XB_XCNT(j)  (256  + 64 * (j))
#define XB_XSUB(j)  (1280 + 64 * (j))
#define XB_XGEN(j)  (2304 + 64 * (j))
#define XB_TOP      3328
#define XB_TOPGEN   3392
#define XCD_BAR_WORDS 3456
#define XB_SPIN_CAP (1u << 18)

__device__ __forceinline__ unsigned xb_ld(unsigned* p)              { return __hip_atomic_load(p, __ATOMIC_RELAXED, __HIP_MEMORY_SCOPE_AGENT); }
__device__ __forceinline__ unsigned xb_add(unsigned* p, unsigned v) { return __hip_atomic_fetch_add(p, v, __ATOMIC_RELAXED, __HIP_MEMORY_SCOPE_AGENT); }
__device__ __forceinline__ unsigned xb_xcc_id() { return (unsigned)__builtin_amdgcn_s_getreg((3 << 11) | 20) & 0xFu; }
#define XB_SPIN(cond, bar) do { unsigned _sp = 0; while (cond) { __builtin_amdgcn_s_sleep(1); \
    if ((++_sp & 255u) == 0u) { if (xb_ld(&(bar)[XB_TMO])) break; if (_sp > XB_SPIN_CAP) { atomicAdd(&(bar)[XB_TMO], 1u); break; } } } } while (0)

struct XcdBarrier {
    unsigned* bar; unsigned x;
    volatile LAS unsigned* st;
};

__device__ __forceinline__ XcdBarrier xcd_barrier_post(unsigned* bar, volatile LAS unsigned* st) {
    XcdBarrier b; b.bar = bar; b.x = xb_xcc_id(); b.st = st;
    if (threadIdx.x == 0) (void)xb_add(&bar[XB_XCNT(b.x)], 1u);
    return b;
}
__device__ __forceinline__ void xcd_barrier_complete(unsigned* bar, unsigned x, unsigned& nloc, unsigned& nx) {
    const unsigned G = gridDim.x * gridDim.y * gridDim.z;
    unsigned sum, cnt, mine, sp = 0u;
    for (;;) {
        sum = 0u; cnt = 0u; mine = 0u;
#pragma unroll
        for (unsigned j = 0; j < 16; ++j) { const unsigned c = xb_ld(&bar[XB_XCNT(j)]); sum += c; cnt += (c > 0u) ? 1u : 0u; mine = (j == x) ? c : mine; }
        if (sum == G) break;
        __builtin_amdgcn_s_sleep(1);
        if ((++sp & 255u) == 0u) { if (xb_ld(&bar[XB_TMO])) break; if (sp > XB_SPIN_CAP) { atomicAdd(&bar[XB_TMO], 1u); break; } }
    }
    nloc = mine > 0u ? mine : 1u; nx = cnt > 0u ? cnt : 1u;
}

__device__ __forceinline__ void xcd_barrier(const XcdBarrier& b) {
    asm volatile("s_waitcnt vmcnt(0)" ::: "memory");
    __syncthreads();
    if (threadIdx.x == 0) {
        unsigned* bar = b.bar;
        __builtin_amdgcn_s_waitcnt(0);
        unsigned nloc = b.st[0], nx = b.st[1];
        if (nloc == 0u) { xcd_barrier_complete(bar, b.x, nloc, nx); b.st[0] = nloc; b.st[1] = nx; }
        const unsigned old = xb_add(&bar[XB_XSUB(b.x)], 1u);
        const unsigned gen = old / nloc;
        if (old + 1u == (gen + 1u) * nloc) {
            __builtin_amdgcn_fence(__ATOMIC_RELEASE, "agent");
            asm volatile("s_waitcnt vmcnt(0)" ::: "memory");
            const unsigned og = xb_add(&bar[XB_TOP], 1u);
            const unsigned tg = og / nx;
            if (og + 1u == (tg + 1u) * nx) xb_add(&bar[XB_TOPGEN], 1u);
            else XB_SPIN(xb_ld(&bar[XB_TOPGEN]) == tg, bar);
            __builtin_amdgcn_fence(__ATOMIC_ACQUIRE, "agent");
            xb_add(&bar[XB_XGEN(b.x)], 1u);
            asm volatile("s_waitcnt vmcnt(0)" ::: "memory");
        } else {
            XB_SPIN(xb_ld(&bar[XB_XGEN(b.x)]) == gen, bar);
            __builtin_amdgcn_fence(__ATOMIC_ACQUIRE, "agent");
            asm volatile("s_waitcnt vmcnt(0)" ::: "memory");
        }
    }
    __syncthreads();
}


struct Args { const float* in[N_IN]; float* out; unsigned char* ws; int ph_lo, ph_hi; };

DI void transpose_item(const float* W, int ldw, int K, bf16* WT, int n_src0, int dst_row0, int k0, LAS float* scr, int lane) {
#pragma unroll 8
    for (int i = 0; i < 32; ++i) { const int kk = 2 * i + (lane >> 5); scr[kk * 33 + (lane & 31)] = W[(size_t)(k0 + kk) * ldw + n_src0 + (lane & 31)]; }
    LDS_WAIT(); asm volatile("" ::: "memory");
    const int c = lane & 7;
#pragma unroll
    for (int j = 0; j < 4; ++j) { const int n = (lane >> 3) + 8 * j; const LAS float* s = scr + (8 * c) * 33 + n;
        v4u o; o.x = pk2(s[0 * 33], s[1 * 33]); o.y = pk2(s[2 * 33], s[3 * 33]); o.z = pk2(s[4 * 33], s[5 * 33]); o.w = pk2(s[6 * 33], s[7 * 33]);
        *(GAS v4u*)(WT + (size_t)(dst_row0 + n) * K + k0 + 8 * c) = o; }
    LDS_WAIT(); asm volatile("" ::: "memory");
}
DI void conv_mat_item(const float* W, int ldw, int K, int ncols, bf16* WT, int mode, int item, LAS float* scr, int lane) {
    const int nblk = ncols / 32, kb = item / nblk, nb = item - kb * nblk, n0 = 32 * nb;
    const int dr = mode == 0 ? n0 : (n0 / 128) * 256 + (mode == 2 ? 128 : 0) + (n0 % 128);
    transpose_item(W, ldw, K, WT, n0, dr, 64 * kb, scr, lane);
}
DI void p0_prologue(const Args& a, LAS unsigned char* lds, int vcu, int G) {
    const int tid = tid_fresh(), lane = tid & 63, wave = __builtin_amdgcn_readfirstlane(tid >> 6);
    unsigned char* ws = a.ws;
    {
        LAS float* sl = (LAS float*)lds;
        LAS float* red = (LAS float*)(lds + 9 * 1024 * 4);
        for (int i = tid; i < 9 * 1024; i += NT) { const int s = i >> 10, k = i & 1023; const float cv = s < 8 ? a.in[I_C][s * 1024 + k] : a.in[I_CCTX][k]; sl[i] = silu_(cv); }
        __syncthreads();
        float* MOD = (float*)(ws + WS_MOD);
        for (int u = vcu; u < 2 * 192; u += G) {
            const int l = u / 192, n0 = (u % 192) * 32, col = tid & 31, kg = tid >> 5;
            const float* w = a.in[I_ADAW] + (size_t)l * 1024 * 6144 + n0 + col;
            float acc[9];
#pragma unroll
            for (int s = 0; s < 9; ++s) acc[s] = 0.f;
#pragma unroll 4
            for (int kk = 0; kk < 64; ++kk) { const int k = kg * 64 + kk; const float wv = w[(size_t)k * 6144];
#pragma unroll
                for (int s = 0; s < 9; ++s) acc[s] += sl[s * 1024 + k] * wv; }
#pragma unroll
            for (int s = 0; s < 9; ++s) red[(kg * 9 + s) * 32 + col] = acc[s];
            __syncthreads();
            if (tid < 288) { const int s = tid >> 5, c2 = tid & 31; float t = a.in[I_ADAB][l * 6144 + n0 + c2];
#pragma unroll
                for (int q = 0; q < 16; ++q) t += red[(q * 9 + s) * 32 + c2];
                MOD[(size_t)(l * 9 + s) * 6144 + n0 + c2] = t; }
            __syncthreads();
        }
    }
    __syncthreads();
    for (int o = vcu * NT + tid; o < 131072; o += G * NT) { const int dgb = o >> 12, j = (o >> 6) & 63, i = o & 63; ((bf16*)(ws + WS_GWT))[o] = (bf16)f2bf(a.in[I_AGATEW][(size_t)dgb * 4096 + i * 64 + j]); }
    for (int o = vcu * NT + tid; o < 16384; o += G * NT) { const int n = 3072 + (o & 15), k = o >> 4; ((bf16*)(ws + WS_WIN0))[(size_t)n * 1024 + k] = (bf16)f2bf(a.in[I_EWIN][(size_t)k * E_IN + n]); }
    LAS float* scr = (LAS float*)(lds + wave * 16384);
    const int gw = vcu * NWAVES + wave, NGW = G * NWAVES;
    constexpr int I0 = 16 * 96, I1 = 16 * 32, I2 = 16 * 88, I3 = 16 * 88, I4 = 44 * 32, I5 = 16 * 129, I6 = 16 * 32;
    constexpr int NITEMS = I0 + I1 + I2 + I3 + I4 + I5 + I6;
    for (int it = gw; it < NITEMS; it += NGW) {
        int r = it;
        if (r < I0) { conv_mat_item(a.in[I_EWIN], E_IN, 1024, NU0, (bf16*)(ws + WS_WIN0), 0, r, scr, lane); continue; } r -= I0;
        if (r < I1) { conv_mat_item(a.in[I_EWOUT], 1024, 1024, 1024, (bf16*)(ws + WS_WOUT0), 0, r, scr, lane); continue; } r -= I1;
        if (r < I2) { conv_mat_item(a.in[I_EFG], DFF, 1024, DFF, (bf16*)(ws + WS_WGU0), 1, r, scr, lane); continue; } r -= I2;
        if (r < I3) { conv_mat_item(a.in[I_EFU], DFF, 1024, DFF, (bf16*)(ws + WS_WGU0), 2, r, scr, lane); continue; } r -= I3;
        if (r < I4) { conv_mat_item(a.in[I_EFD], 1024, DFF, 1024, (bf16*)(ws + WS_WDN0), 0, r, scr, lane); continue; } r -= I4;
        if (r < I5) { conv_mat_item(a.in[I_OWIN], O_IN, 1024, O_IN, (bf16*)(ws + WS_WIN1), 0, r, scr, lane); continue; } r -= I5;
        conv_mat_item(a.in[I_OWOUT], 1024, 1024, 1024, (bf16*)(ws + WS_WOUT1), 0, r, scr, lane);
    }
}
DI void moe_weight_copies(const Args& a, LAS unsigned char* lds, int vcu, int G) {
    const int tid = tid_fresh(), lane = tid & 63, wave = __builtin_amdgcn_readfirstlane(tid >> 6);
    LAS float* scr = (LAS float*)(lds + wave * 16384);
    const int gw = vcu * NWAVES + wave, NGW = G * NWAVES;
    constexpr int IG = 16 * 88, ID = 44 * 32, IE = 2 * IG + ID;
    for (int it = gw; it < NEXP * IE; it += NGW) {
        const int e = it / IE; int r = it - e * IE;
        bf16* gu = (bf16*)(a.ws + WS_WGU1) + (size_t)e * 5632 * 1024; bf16* dn = (bf16*)(a.ws + WS_WDN1) + (size_t)e * 1024 * DFF;
        if (r < IG) { conv_mat_item(a.in[I_MG] + (size_t)e * 1024 * DFF, DFF, 1024, DFF, gu, 1, r, scr, lane); continue; } r -= IG;
        if (r < IG) { conv_mat_item(a.in[I_MU] + (size_t)e * 1024 * DFF, DFF, 1024, DFF, gu, 2, r, scr, lane); continue; } r -= IG;
        conv_mat_item(a.in[I_MD] + (size_t)e * DFF * 1024, 1024, DFF, 1024, dn, 0, r, scr, lane);
    }
}

template <int WHICH> DI void norm_phase(const Args& a, LAS unsigned char* lds, int vcu, int G) {
    const int tid = tid_fresh(), lane = tid & 63, wave = __builtin_amdgcn_readfirstlane(tid >> 6);
    const int gw = vcu * NWAVES + wave, NGW = G * NWAVES;
    unsigned char* ws = a.ws;
    const float* MOD = (const float*)(ws + WS_MOD);
    constexpr int L = WHICH >= 2 ? 1 : 0, FF = (WHICH & 1), NROWS = WHICH == 3 ? ML : M0, NR = WHICH == 3 ? 2 : 3;
    const float* g = a.in[FF ? I_NFFN : I_NMIX] + L * 1024;
    LAS float* RWt = (LAS float*)lds;
    if (WHICH == 3) { for (int i = tid; i < 8192; i += NT) RWt[(i & 7) * 1024 + (i >> 3)] = a.in[I_RW][i]; __syncthreads(); }
    f32x4 gg[4];
#pragma unroll
    for (int j = 0; j < 4; ++j) gg[j] = *(const f32x4*)(g + 4 * lane + 256 * j);
    for (int rb = gw; rb < NROWS; rb += NR * NGW) {
        f32x4 v[NR][4]; float ss[NR];
#pragma unroll
        for (int q = 0; q < NR; ++q) { const int r = rb + q * NGW; ss[q] = 0.f;
            if (r < NROWS) { const bool lat = r < ML; const float* src;
                if (WHICH == 0) src = lat ? a.in[I_X] + (size_t)r * D : a.in[I_CTX] + (size_t)(r - ML) * D;
                else src = lat ? a.out + (size_t)r * D : (const float*)(ws + WS_HCTX) + (size_t)(r - ML) * D;
                const f32x4* xr = (const f32x4*)src + lane;
#pragma unroll
                for (int j = 0; j < 4; ++j) v[q][j] = xr[64 * j];
                if (WHICH == 1 && !lat) {
                    const f32x4* cr = (const f32x4*)(a.in[I_CTX] + (size_t)(r - ML) * D) + lane;
                    const f32x4* pr = (const f32x4*)((const float*)(ws + WS_PART0) + (size_t)(r - ML) * D) + lane;
#pragma unroll
                    for (int j = 0; j < 4; ++j) { v[q][j] = cr[64 * j];
#pragma unroll
                        for (int s4 = 0; s4 < 4; ++s4) v[q][j] += pr[(size_t)s4 * 2048 * 256 + 64 * j];
                        ((f32x4*)((float*)(ws + WS_HCTX) + (size_t)(r - ML) * D) + lane)[64 * j] = v[q][j]; } }
                if (WHICH == 2 && !lat) {
                    const f32x4* pr = (const f32x4*)((const float*)(ws + WS_PART0) + (size_t)(r - ML) * D) + lane;
#pragma unroll
                    for (int s8 = 0; s8 < 8; ++s8)
#pragma unroll
                        for (int j = 0; j < 4; ++j) v[q][j] += pr[(size_t)s8 * 2048 * 256 + 64 * j]; } } }
#pragma unroll
        for (int q = 0; q < NR; ++q) if (rb + q * NGW < NROWS) {
#pragma unroll
            for (int j = 0; j < 4; ++j) ss[q] += (v[q][j].x * v[q][j].x + v[q][j].y * v[q][j].y) + (v[q][j].z * v[q][j].z + v[q][j].w * v[q][j].w); }
#pragma unroll
        for (int q = 0; q < NR; ++q) ss[q] = wave_sum(ss[q]);
#pragma unroll
        for (int q = 0; q < NR; ++q) { const int r = rb + q * NGW;
            if (r < NROWS) { const bool lat = r < ML; const int s = lat ? (r >> 11) : 8;
                const float rstd = rsqrtf(ss[q] * (1.0f / D) + EPS);
                const float* shift = MOD + (size_t)(L * 9 + s) * 6144 + (FF ? 3 : 0) * 1024; const float* scale = shift + 1024;
                int rd = r;
                if (WHICH == 2 && lat) { const int t = r & 2047; rd = (r & ~2047) + (t & 63) * 32 + (t >> 6); }
                bf16* dst = (bf16*)(ws + (WHICH == 3 ? WS_XN2 : WS_XN)) + (size_t)rd * D;
#pragma unroll
                for (int j = 0; j < 4; ++j) { const int k = 4 * lane + 256 * j;
                    const f32x4 sh = *(const f32x4*)(shift + k), sc = *(const f32x4*)(scale + k);
                    v[q][j] = (v[q][j] * rstd) * gg[j] * (sc + 1.0f) + sh;
                    v2u o; o.x = pk2(v[q][j].x, v[q][j].y); o.y = pk2(v[q][j].z, v[q][j].w);
                    *(v2u*)(dst + k) = o; }
                if constexpr (WHICH == 3) {
                    float sm[8];
#pragma unroll
                    for (int n = 0; n < 8; ++n) { float acc = 0.f;
#pragma unroll
                        for (int j = 0; j < 4; ++j) { const f32x4 w = *(const LAS f32x4*)(RWt + n * 1024 + 4 * lane + 256 * j); acc += (v[q][j].x * w.x + v[q][j].y * w.y) + (v[q][j].z * w.z + v[q][j].w * w.w); }
                        sm[n] = acc; }
#pragma unroll
                    for (int n = 0; n < 8; ++n) sm[n] = wave_sum(sm[n]);
                    if (lane == 0) {
                        float lg[8];
#pragma unroll
                        for (int n = 0; n < 8; ++n) lg[n] = sm[n] + a.in[I_RB][n];
                        int e0 = 0; float v0 = lg[0];
#pragma unroll
                        for (int n = 1; n < 8; ++n) if (lg[n] > v0) { v0 = lg[n]; e0 = n; }
                        int e1 = -1; float v1 = -3.0e38f;
#pragma unroll
                        for (int n = 0; n < 8; ++n) if (n != e0 && lg[n] > v1) { v1 = lg[n]; e1 = n; }
                        const float p0 = 1.0f / (1.0f + expf(v1 - v0)), p1 = 1.0f - p0;
                        unsigned* ctl = (unsigned*)(ws + WS_CTL);
                        const unsigned s0 = atomicAdd(ctl + CW_CNT + 64 * e0, 1u), s1 = atomicAdd(ctl + CW_CNT + 64 * e1, 1u);
                        unsigned* tk = (unsigned*)(ws + WS_TOPK) + (size_t)r * 8;
                        tk[0] = (unsigned)e0; tk[1] = (unsigned)e1; tk[2] = __builtin_bit_cast(unsigned, p0); tk[3] = __builtin_bit_cast(unsigned, p1); tk[4] = s0; tk[5] = s1;
                    } }
            } }
    }
}


#define MFMA16(A_, B_, C_) __builtin_amdgcn_mfma_f32_16x16x32_bf16((A_), (B_), (C_), 0, 0, 0)
DI bf16x8 ldfrag(const LAS unsigned char* base, int stride, int r0, int k0, int lane) { return *(const LAS bf16x8*)(base + (r0 + (lane & 15)) * stride + (k0 + (lane >> 4) * 8) * 2); }


typedef short s16x4_t __attribute__((ext_vector_type(4)));
DI bf16x8 ldfrag_tr(const LAS unsigned char* base, int stride, int k0, int c0, int lane) {
    const LAS unsigned char* p = base + (k0 + 8 * (lane >> 4) + ((lane & 15) >> 2)) * stride + (c0 + 4 * (lane & 3)) * 2;
    const s16x4_t lo = __builtin_amdgcn_ds_read_tr16_b64_v4i16((LAS s16x4_t*)p), hi = __builtin_amdgcn_ds_read_tr16_b64_v4i16((LAS s16x4_t*)(p + 4 * stride));
    bf16x8 r; r[0] = lo[0]; r[1] = lo[1]; r[2] = lo[2]; r[3] = lo[3]; r[4] = hi[0]; r[5] = hi[1]; r[6] = hi[2]; r[7] = hi[3]; return r;
}

DI void scan1_prep_phase(const Args& a, LAS unsigned char* lds, int vcu, int G) {
    const int tid = tid_fresh(), lane = tid & 63, wave = __builtin_amdgcn_readfirstlane(tid >> 6);
    unsigned char* ws = a.ws;
    const bf16* U = (const bf16*)(ws + WS_U);
    constexpr int IMG = 64 * 272;
    LAS unsigned char* QDs = lds;
    LAS unsigned char* KDs = lds + 2 * IMG;
    LAS unsigned char* KTs = lds + 4 * IMG;
    LAS float* tot = (LAS float*)(lds + 6 * IMG);
    const float* lbl = a.in[I_LBLOG];
    for (int u = vcu; u < 2304; u += G) {
        int r = u; const int chunk = r % 36; r /= 36; const int h = r & 3; r >>= 2; const int b = r & 7; const int type = r >> 3;
        const int DKS = type ? 6 : 7, DK = 1 << DKS;
        const int row0 = chunk < 4 ? ML + b * CTXL + chunk * 64 : b * SEQ + (chunk - 4) * 64;
        const bool lat = chunk >= 4;
        LDS_BARRIER();
        if (type == 0) {
            const int cc = h * 128 + 2 * lane;
            const float lb0 = frcp(1.0f + __expf(lbl[cc] - lbl[512 + cc])), lb1 = frcp(1.0f + __expf(lbl[cc + 1] - lbl[512 + cc + 1]));
            unsigned ufl[2][8], uq[8];
#pragma unroll
            for (int i = 0; i < 8; ++i) { const bf16* ur = U + (size_t)(row0 + wave * 8 + i) * NU1S; ufl[0][i] = *(const unsigned*)(ur + 512 + cc); ufl[1][i] = *(const unsigned*)(ur + 1024 + cc); uq[i] = lat ? *(const unsigned*)(ur + cc) : 0u; }
            float E0[2][8], E1[2][8], k0[2][8], k1[2][8];
#pragma unroll
            for (int d = 0; d < 2; ++d) {
#pragma unroll
                for (int i = 0; i < 8; ++i) { const float s0 = sigm(bflo(ufl[d][i])), s1 = sigm(bfhi(ufl[d][i]));
                    E0[d][i] = lb0 + (1.0f - lb0) * s0; E1[d][i] = lb1 + (1.0f - lb1) * s1; k0[d][i] = (1.0f - lb0) * (1.0f - s0); k1[d][i] = (1.0f - lb1) * (1.0f - s1); }
                if (d == 0) {
#pragma unroll
                    for (int i = 1; i < 8; ++i) { E0[0][i] *= E0[0][i - 1]; E1[0][i] *= E1[0][i - 1]; }
                    tot[wave * 128 + 2 * lane] = E0[0][7]; tot[wave * 128 + 2 * lane + 1] = E1[0][7];
                } else {
#pragma unroll
                    for (int i = 6; i >= 0; --i) { E0[1][i] *= E0[1][i + 1]; E1[1][i] *= E1[1][i + 1]; }
                    tot[2048 + wave * 128 + 2 * lane] = E0[1][0]; tot[2048 + wave * 128 + 2 * lane + 1] = E1[1][0];
                }
            }
            LDS_BARRIER();
            float q0[8], q1[8];
#pragma unroll
            for (int i = 0; i < 8; ++i) { q0[i] = silu_(bflo(uq[i])) * 0.08838834764831845f; q1[i] = silu_(bfhi(uq[i])) * 0.08838834764831845f; }
#pragma unroll
            for (int d = 0; d < 2; ++d) {
                float pre0 = 1.f, pre1 = 1.f, all0 = 1.f, all1 = 1.f;
#pragma unroll
                for (int w = 0; w < 8; ++w) { const float t0 = tot[d * 2048 + w * 128 + 2 * lane], t1 = tot[d * 2048 + w * 128 + 2 * lane + 1]; all0 *= t0; all1 *= t1;
                    const bool before = d ? (w > wave) : (w < wave); pre0 *= before ? t0 : 1.f; pre1 *= before ? t1 : 1.f; }
#pragma unroll
                for (int i = 0; i < 8; ++i) { const int c = wave * 8 + i;
                    const float e0 = pre0 * E0[d][i], e1 = pre1 * E1[d][i], r0 = frcp(e0), r1 = frcp(e1);
                    *(LAS unsigned*)(QDs + d * IMG + c * 272 + lane * 4) = pk2(q0[i] * e0, q1[i] * e1);
                    *(LAS unsigned*)(KDs + d * IMG + c * 272 + lane * 4) = pk2(k0[d][i] * r0, k1[d][i] * r1);
                    *(LAS unsigned*)(KTs + d * IMG + c * 272 + lane * 4) = pk2(k0[d][i] * all0 * r0, k1[d][i] * all1 * r1); }
                if (wave == 0) { float* dt = (float*)(ws + WS_DT1) + (size_t)(((b * 4 + h) * 2 + d) * 36 + chunk) * 128 + 2 * lane; dt[0] = all0; dt[1] = all1; }
            }
        } else {
            const int cp = tid & 31, tg = tid >> 5, cc = h * 64 + 2 * cp;
            float lf0[2][4], lf1[2][4], k0[4], k1[4], q0[4], q1[4];
            v4u lrv[4][4];
#pragma unroll
            for (int i = 0; i < 4; ++i) { const bf16* ur = U + (size_t)(row0 + tg * 4 + i) * NU1S;
#pragma unroll
                for (int p = 0; p < 4; ++p) lrv[i][p] = *(const v4u*)(ur + 4096 + 8 * p);
                const unsigned uk = *(const unsigned*)(ur + 2816 + cc), uqv = lat ? *(const unsigned*)(ur + 2560 + cc) : 0u;
                k0[i] = bflo(uk); k1[i] = bfhi(uk); q0[i] = bflo(uqv) * 0.125f; q1[i] = bfhi(uqv) * 0.125f; }
#pragma unroll
            for (int d = 0; d < 2; ++d) {
                float w2a[16], w2b[16];
#pragma unroll
                for (int rr = 0; rr < 16; ++rr) { w2a[rr] = a.in[I_DGW2][(d * 16 + rr) * 256 + cc]; w2b[rr] = a.in[I_DGW2][(d * 16 + rr) * 256 + cc + 1]; }
                const float bz0 = a.in[I_DGB2][d * 256 + cc], bz1 = a.in[I_DGB2][d * 256 + cc + 1];
#pragma unroll
                for (int i = 0; i < 4; ++i) { const v4u la = lrv[i][2 * d], lbv = lrv[i][2 * d + 1];
                    const float lr[16] = {bflo(la.x), bfhi(la.x), bflo(la.y), bfhi(la.y), bflo(la.z), bfhi(la.z), bflo(la.w), bfhi(la.w), bflo(lbv.x), bfhi(lbv.x), bflo(lbv.y), bfhi(lbv.y), bflo(lbv.z), bfhi(lbv.z), bflo(lbv.w), bfhi(lbv.w)};
                    float z0 = bz0, z1 = bz1;
#pragma unroll
                    for (int rr = 0; rr < 16; ++rr) { z0 += lr[rr] * w2a[rr]; z1 += lr[rr] * w2b[rr]; }
                    lf0[d][i] = -softplus_fast(-z0) * (1.0f / 16.0f); lf1[d][i] = -softplus_fast(-z1) * (1.0f / 16.0f); }
                if (d == 0) {
#pragma unroll
                    for (int i = 1; i < 4; ++i) { lf0[0][i] += lf0[0][i - 1]; lf1[0][i] += lf1[0][i - 1]; }
                    tot[tg * 128 + 2 * cp] = lf0[0][3]; tot[tg * 128 + 2 * cp + 1] = lf1[0][3];
                } else {
#pragma unroll
                    for (int i = 2; i >= 0; --i) { lf0[1][i] += lf0[1][i + 1]; lf1[1][i] += lf1[1][i + 1]; }
                    tot[2048 + tg * 128 + 2 * cp] = lf0[1][0]; tot[2048 + tg * 128 + 2 * cp + 1] = lf1[1][0];
                }
            }
            LDS_BARRIER();
#pragma unroll
            for (int d = 0; d < 2; ++d) {
                float pre0 = 0.f, pre1 = 0.f, all0 = 0.f, all1 = 0.f;
#pragma unroll
                for (int w = 0; w < 16; ++w) { const float t0 = tot[d * 2048 + w * 128 + 2 * cp], t1 = tot[d * 2048 + w * 128 + 2 * cp + 1]; all0 += t0; all1 += t1;
                    const bool before = d ? (w > tg) : (w < tg); pre0 += before ? t0 : 0.f; pre1 += before ? t1 : 0.f; }
                const float el0 = __expf(all0), el1 = __expf(all1);
#pragma unroll
                for (int i = 0; i < 4; ++i) { const int c = tg * 4 + i;
                    const float e0 = __expf(pre0 + lf0[d][i]), e1 = __expf(pre1 + lf1[d][i]), r0 = frcp(e0), r1 = frcp(e1);
                    *(LAS unsigned*)(QDs + d * IMG + c * 272 + cp * 4) = pk2(q0[i] * e0, q1[i] * e1);
                    *(LAS unsigned*)(KDs + d * IMG + c * 272 + cp * 4) = pk2(k0[i] * r0, k1[i] * r1);
                    *(LAS unsigned*)(KTs + d * IMG + c * 272 + cp * 4) = pk2(k0[i] * el0 * r0, k1[i] * el1 * r1); }
                if (tg == 0) { float* dt = (float*)(ws + WS_DT1) + (size_t)((64 + (b * 4 + h) * 2 + d) * 36 + chunk) * 128 + 2 * cp; dt[0] = el0; dt[1] = el1; }
            }
        }
        LDS_BARRIER();
#pragma unroll
        for (int d = 0; d < 2; ++d) {
            const int cidT = (b * 4 + h) * 2 + d, cid = type * 64 + cidT;
            { v4u* KTg = (v4u*)(type ? ws + WS_KTG : ws + WS_KTH) + (size_t)(cidT * 36 + chunk) * (DK * 8);
              for (int i = tid; i < DK * 8; i += NT) { const int c = i >> (DKS - 3), kk = (i & ((DK >> 3) - 1)) * 8; KTg[i] = *(const LAS v4u*)(KTs + d * IMG + c * 272 + kk * 2); } }
            if (lat) {
                const int lc = chunk - 4;
                { v4u* QDg = (v4u*)(type ? ws + WS_QDG : ws + WS_QDH) + (size_t)(cidT * 32 + lc) * (DK * 8);
                  for (int i = tid; i < DK * 8; i += NT) { const int c = i >> (DKS - 3), kk = (i & ((DK >> 3) - 1)) * 8; QDg[i] = *(const LAS v4u*)(QDs + d * IMG + c * 272 + kk * 2); } }
                const int mt = wave >> 1, nts = (wave & 1) * 2;
                f32x4 acc0 = {0.f, 0.f, 0.f, 0.f}, acc1 = {0.f, 0.f, 0.f, 0.f};
                for (int ks = 0; ks < (DK >> 5); ++ks) { const bf16x8 fa = ldfrag(QDs + d * IMG, 272, mt * 16, ks * 32, lane), fb0 = ldfrag(KDs + d * IMG, 272, nts * 16, ks * 32, lane), fb1 = ldfrag(KDs + d * IMG, 272, nts * 16 + 16, ks * 32, lane);
                    acc0 = MFMA16(fa, fb0, acc0); acc1 = MFMA16(fa, fb1, acc1); }
                bf16* Ag = (bf16*)(ws + WS_A1) + (size_t)(cid * 32 + lc) * 4096;
#pragma unroll
                for (int i = 0; i < 4; ++i) { const int c = mt * 16 + (lane >> 4) * 4 + i, j0 = nts * 16 + (lane & 15), j1 = j0 + 16;
                    const bool kp0 = d ? (j0 >= c) : (j0 <= c), kp1 = d ? (j1 >= c) : (j1 <= c);
                    Ag[c * 64 + j0] = (bf16)f2bf(kp0 ? acc0[i] : 0.f); Ag[c * 64 + j1] = (bf16)f2bf(kp1 ? acc1[i] : 0.f); }
            }
        }
    }
}

template <int TYPE> DI void scan1_chain_unit(const Args& a, LAS unsigned char* lds, int u) {
    const int tid = tid_fresh(), lane = tid & 63, wave = __builtin_amdgcn_readfirstlane(tid >> 6);
    unsigned char* ws = a.ws;
    const bf16* U = (const bf16*)(ws + WS_U);
    constexpr int BUFSZ = 54784, O_QD = 0, O_KT = 17408, O_A = 35840, O_VT = 45056, O_DT = 54272, O_ST = 2 * BUFSZ, STSZ = 17408;
    {
        constexpr int type = TYPE; const int rem = u & 127, b = rem >> 4, h = (rem >> 2) & 3, d = (rem >> 1) & 1, sl = rem & 1;
        constexpr int DKS = type ? 6 : 7, DK = 1 << DKS; const int cidT = (b * 4 + h) * 2 + d, cid = type * 64 + cidT;
        const int vcol = (type ? 3072 : 1536) + h * 128 + sl * 64;
        const v4u* QDg = (const v4u*)(type ? ws + WS_QDG : ws + WS_QDH) + (size_t)cidT * 32 * (DK * 8);
        const v4u* KTg = (const v4u*)(type ? ws + WS_KTG : ws + WS_KTH) + (size_t)cidT * 36 * (DK * 8);
        const v4u* Ag = (const v4u*)(ws + WS_A1) + (size_t)cid * 32 * 512;
        const float* DTg = (const float*)(ws + WS_DT1) + (size_t)cid * 36 * 128;
        bf16* Og = (bf16*)(ws + WS_O1) + (size_t)d * ML * 1024 + type * 512 + h * 128 + sl * 64;
        constexpr int NKW = type ? 1 : 2;
        f32x4 S[NKW][4];
#pragma unroll
        for (int i = 0; i < NKW; ++i)
#pragma unroll
            for (int j = 0; j < 4; ++j) S[i][j] = (f32x4){0.f, 0.f, 0.f, 0.f};
        LDS_BARRIER();
        for (int i = tid; i < STSZ / 4; i += NT) ((LAS unsigned*)(lds + O_ST))[i] = 0u;
        v4u rq[2], rk[2], ra, rv; f32x4 rd;
#define chunk_of(n_) ((n_) < 4 ? (d ? 3 - (n_) : (n_)) : 4 + (d ? 31 - ((n_) - 4) : (n_) - 4))
#define S1_LOAD(n_) do { const int ck_ = chunk_of(n_); const bool lat_ = ck_ >= 4; \
            const size_t row0_ = lat_ ? (size_t)b * SEQ + (ck_ - 4) * 64 : (size_t)ML + b * CTXL + ck_ * 64; \
            rk[0] = KTg[(size_t)ck_ * (DK * 8) + tid]; if (type == 0) rk[1] = KTg[(size_t)ck_ * (DK * 8) + 512 + tid]; \
            rv = *(const v4u*)(U + (row0_ + lane) * NU1S + vcol + wave * 8); \
            if (tid < 32) rd = *(const f32x4*)(DTg + (size_t)ck_ * 128 + tid * 4); \
            if (lat_) { rq[0] = QDg[(size_t)(ck_ - 4) * (DK * 8) + tid]; if (type == 0) rq[1] = QDg[(size_t)(ck_ - 4) * (DK * 8) + 512 + tid]; ra = Ag[(size_t)(ck_ - 4) * 512 + tid]; } } while (0)
#define S1_STORE(n_, buf_) do { LAS unsigned char* B_ = lds + (buf_) * BUFSZ; const bool lat_ = (n_) >= 4; \
            if (type == 0) { const int c_ = tid >> 4, kk_ = (tid & 15) * 8; *(LAS v4u*)(B_ + O_KT + c_ * 272 + kk_ * 2) = rk[0]; *(LAS v4u*)(B_ + O_KT + (c_ + 32) * 272 + kk_ * 2) = rk[1]; } \
            else { const int c_ = tid >> 3, kk_ = (tid & 7) * 8; *(LAS v4u*)(B_ + O_KT + c_ * 272 + kk_ * 2) = rk[0]; } \
            *(LAS v4u*)(B_ + O_VT + lane * 144 + wave * 16) = rv; \
            if (tid < 32) *(LAS f32x4*)(B_ + O_DT + tid * 16) = rd; \
            if (lat_) { if (type == 0) { const int c_ = tid >> 4, kk_ = (tid & 15) * 8; *(LAS v4u*)(B_ + O_QD + c_ * 272 + kk_ * 2) = rq[0]; *(LAS v4u*)(B_ + O_QD + (c_ + 32) * 272 + kk_ * 2) = rq[1]; } \
                        else { const int c_ = tid >> 3, kk_ = (tid & 7) * 8; *(LAS v4u*)(B_ + O_QD + c_ * 272 + kk_ * 2) = rq[0]; } \
                        { const int c_ = tid >> 3, jj_ = (tid & 7) * 8; *(LAS v4u*)(B_ + O_A + c_ * 144 + jj_ * 2) = ra; } } } while (0)
        S1_LOAD(0); S1_STORE(0, 0);
        LDS_BARRIER();
        for (int n = 0; n < 36; ++n) {
            const int cur = n & 1, nxt = cur ^ 1; const bool lat = n >= 4;
            const LAS unsigned char* Bc = lds + cur * BUFSZ; const LAS unsigned char* Stc = lds + O_ST + cur * STSZ;
            if (n + 1 < 36) S1_LOAD(n + 1);
            if (wave < 4) {
                if (lat) {
                    const int mb = (wave >> 1) * 32, nb = (wave & 1) * 32;
                    f32x4 o[2][2];
#pragma unroll
                    for (int i = 0; i < 2; ++i)
#pragma unroll
                        for (int j = 0; j < 2; ++j) o[i][j] = (f32x4){0.f, 0.f, 0.f, 0.f};
#pragma unroll
                    for (int ks = 0; ks < (DK >> 5); ++ks) { const bf16x8 fa0 = ldfrag(Bc + O_QD, 272, mb, ks * 32, lane), fa1 = ldfrag(Bc + O_QD, 272, mb + 16, ks * 32, lane), fb0 = ldfrag(Stc, 272, nb, ks * 32, lane), fb1 = ldfrag(Stc, 272, nb + 16, ks * 32, lane);
                        o[0][0] = MFMA16(fa0, fb0, o[0][0]); o[0][1] = MFMA16(fa0, fb1, o[0][1]); o[1][0] = MFMA16(fa1, fb0, o[1][0]); o[1][1] = MFMA16(fa1, fb1, o[1][1]); }
#pragma unroll
                    for (int ks = 0; ks < 2; ++ks) { const bf16x8 fa0 = ldfrag(Bc + O_A, 144, mb, ks * 32, lane), fa1 = ldfrag(Bc + O_A, 144, mb + 16, ks * 32, lane), fb0 = ldfrag_tr(Bc + O_VT, 144, ks * 32, nb, lane), fb1 = ldfrag_tr(Bc + O_VT, 144, ks * 32, nb + 16, lane);
                        o[0][0] = MFMA16(fa0, fb0, o[0][0]); o[0][1] = MFMA16(fa0, fb1, o[0][1]); o[1][0] = MFMA16(fa1, fb0, o[1][0]); o[1][1] = MFMA16(fa1, fb1, o[1][1]); }
                    const int ck = chunk_of(n); const size_t row0 = (size_t)b * SEQ + (ck - 4) * 64;
#pragma unroll
                    for (int mi = 0; mi < 2; ++mi)
#pragma unroll
                        for (int i = 0; i < 4; ++i) { bf16* op = Og + (row0 + mb + mi * 16 + (lane >> 4) * 4 + i) * 1024 + nb + (lane & 15); op[0] = (bf16)f2bf(o[mi][0][i]); op[16] = (bf16)f2bf(o[mi][1][i]); }
                }
            } else {
                const int kt0 = (wave - 4) * NKW;
                bf16x8 fv[4][2];
#pragma unroll
                for (int nt = 0; nt < 4; ++nt)
#pragma unroll
                    for (int ks = 0; ks < 2; ++ks) fv[nt][ks] = ldfrag_tr(Bc + O_VT, 144, ks * 32, nt * 16, lane);
#pragma unroll
                for (int i = 0; i < NKW; ++i) { const int kt = kt0 + i;
                    const f32x4 dt = *(const LAS f32x4*)(Bc + O_DT + (kt * 16 + (lane >> 4) * 4) * 4);
                    const bf16x8 fk0 = ldfrag_tr(Bc + O_KT, 272, 0, kt * 16, lane), fk1 = ldfrag_tr(Bc + O_KT, 272, 32, kt * 16, lane);
#pragma unroll
                    for (int nt = 0; nt < 4; ++nt) { f32x4 sv = S[i][nt] * dt; sv = MFMA16(fk0, fv[nt][0], sv); sv = MFMA16(fk1, fv[nt][1], sv); S[i][nt] = sv; } }
#pragma unroll
                for (int i = 0; i < NKW; ++i)
#pragma unroll
                    for (int nt = 0; nt < 4; ++nt) { const int kt = kt0 + i; v2u p; p.x = pk2(S[i][nt][0], S[i][nt][1]); p.y = pk2(S[i][nt][2], S[i][nt][3]);
                        *(LAS v2u*)(lds + O_ST + nxt * STSZ + (nt * 16 + (lane & 15)) * 272 + (kt * 16 + (lane >> 4) * 4) * 2) = p; }
            }
            if (n + 1 < 36) S1_STORE(n + 1, nxt);
            LDS_BARRIER();
        }
#undef S1_LOAD
#undef chunk_of
#undef S1_STORE
    }
}

DI void scan1_chain_phase(const Args& a, LAS unsigned char* lds, int vcu, int G) {
    for (int u = vcu; u < 256; u += G) { if (u < 128) scan1_chain_unit<0>(a, lds, u); else scan1_chain_unit<1>(a, lds, u); }
}


DI void dn_prep_unit(const Args& a, LAS unsigned char* lds, int u) {
    const int tid = tid_fresh(), lane = tid & 63, wave = __builtin_amdgcn_readfirstlane(tid >> 6);
    unsigned char* ws = a.ws;
    const bf16* U = (const bf16*)(ws + WS_U); const float* cw = a.in[I_BCONVW];
    LAS unsigned char* Qs = lds;
    LAS unsigned char* Ks = lds + 17408;
    LAS float* KK = (LAS float*)(lds + 34816);
    LAS float* QK = KK + 64 * 65;
    LAS float* Ls = QK + 64 * 65;
    LAS unsigned char* Tn = (LAS unsigned char*)(Ls + 8192);
    LAS float* g_s = (LAS float*)(Tn + 2 * 9216);
    LAS float* be_s = g_s + 128;
    const int chunk = u % 36, bh = u / 36, b = bh >> 2, h = bh & 3;
    const int row0 = chunk < 4 ? ML + b * CTXL + chunk * 64 : b * SEQ + (chunk - 4) * 64;
    const int seg0 = chunk < 4 ? ML + b * CTXL : b * SEQ, len = chunk < 4 ? CTXL : SEQ;
    LDS_BARRIER();
#if defined(SUBP) && SUBP == 3
    for (int rp_ = 0; rp_ < 2; ++rp_)
#endif
    {
        float cwv[3][4][2];
#pragma unroll
        for (int part = 0; part < 3; ++part)
#pragma unroll
            for (int j = 0; j < 4; ++j) { const int c0 = part * 512 + h * 128 + 2 * lane; cwv[part][j][0] = cw[j * 1536 + c0]; cwv[part][j][1] = cw[j * 1536 + c0 + 1]; }
        unsigned xs[11][3];
        const int tb = row0 - seg0 + wave * 8 - 2;
#pragma unroll
        for (int i = 0; i < 11; ++i) { const int tt = tb + i; const bool ok = tt >= 0 && tt < len;
#pragma unroll
            for (int part = 0; part < 3; ++part) xs[i][part] = ok ? *(const unsigned*)(U + (size_t)(seg0 + tt) * NU0S + 1024 + part * 512 + h * 128 + 2 * lane) : 0u; }
#pragma unroll
        for (int i = 0; i < 8; ++i) {
            const int c = wave * 8 + i, r = row0 + c;
            float val[3][2];
#pragma unroll
            for (int part = 0; part < 3; ++part) { float a0 = 0.f, a1 = 0.f;
#pragma unroll
                for (int j = 0; j < 4; ++j) { a0 += cwv[part][j][0] * bflo(xs[i + j][part]); a1 += cwv[part][j][1] * bfhi(xs[i + j][part]); }
                val[part][0] = silu_(a0); val[part][1] = silu_(a1); }
            const float sq = wave_sum(val[0][0] * val[0][0] + val[0][1] * val[0][1]), sk = wave_sum(val[1][0] * val[1][0] + val[1][1] * val[1][1]);
            const float fq = rsqrtf(sq + EPS) * 0.08838834764831845f, fk = rsqrtf(sk + EPS);
            const size_t o = (size_t)r * 512 + h * 128 + 2 * lane;
            const unsigned pq = pk2(val[0][0] * fq, val[0][1] * fq), pk = pk2(val[1][0] * fk, val[1][1] * fk);
            *(unsigned*)((bf16*)(ws + WS_DNQ) + o) = pq; *(unsigned*)((bf16*)(ws + WS_DNK) + o) = pk;
            *(unsigned*)((bf16*)(ws + WS_DNV) + o) = pk2(val[2][0], val[2][1]);
            *(LAS unsigned*)(Qs + c * 272 + lane * 4) = pq; *(LAS unsigned*)(Ks + c * 272 + lane * 4) = pk;
        }
    }
    if (tid < 128) { const int d = tid >> 6, c = tid & 63; const bf16* ur = U + (size_t)(row0 + c) * NU0S + 3072;
        be_s[tid] = sigm(bf2f(ur[d * 4 + h]));
        g_s[tid] = -expf(a.in[I_BALOG][d * 4 + h]) * softplus_(bf2f(ur[8 + d * 4 + h]) + a.in[I_BDT][d * 4 + h]); }
    LDS_BARRIER();
    {
        const int mt = wave >> 1, nts = (wave & 1) * 2;
        f32x4 kk0 = {0.f, 0.f, 0.f, 0.f}, kk1 = kk0, qk0 = kk0, qk1 = kk0;
#pragma unroll
        for (int ks = 0; ks < 4; ++ks) { const bf16x8 fk = ldfrag(Ks, 272, mt * 16, ks * 32, lane), fq = ldfrag(Qs, 272, mt * 16, ks * 32, lane), fb0 = ldfrag(Ks, 272, nts * 16, ks * 32, lane), fb1 = ldfrag(Ks, 272, nts * 16 + 16, ks * 32, lane);
            kk0 = MFMA16(fk, fb0, kk0); kk1 = MFMA16(fk, fb1, kk1); qk0 = MFMA16(fq, fb0, qk0); qk1 = MFMA16(fq, fb1, qk1); }
#pragma unroll
        for (int i = 0; i < 4; ++i) { const int ri = mt * 16 + (lane >> 4) * 4 + i, cj = nts * 16 + (lane & 15);
            KK[ri * 65 + cj] = kk0[i]; KK[ri * 65 + cj + 16] = kk1[i]; QK[ri * 65 + cj] = qk0[i]; QK[ri * 65 + cj + 16] = qk1[i]; }
    }
    float gcv = 0.f;
    if (wave < 2) { const int d = wave, c = d ? 63 - lane : lane; float x = g_s[d * 64 + c];
#pragma unroll
        for (int o = 1; o < 64; o <<= 1) { const float y = __shfl_up(x, o); if (lane >= o) x += y; }
        gcv = x; }
    LDS_BARRIER();
    if (wave < 2) { const int d = wave, c = d ? 63 - lane : lane; g_s[d * 64 + c] = gcv; }
    LDS_BARRIER();
    const size_t ud = (size_t)bh * 36 + chunk;
    LAS unsigned char* L21i = (LAS unsigned char*)(be_s + 128);
    LAS unsigned char* T11T = L21i + 5120;
    LAS unsigned char* T22i = T11T + 5120;
    LAS unsigned char* MTi = T22i + 5120;
    for (int i = tid; i < 2 * 9216 / 4; i += NT) ((LAS unsigned*)Tn)[i] = 0u;
    for (int idx = tid; idx < 2048; idx += NT) { const int d = idx >> 10, i = (idx >> 4) & 63, j4 = (idx & 15) * 4, ni = d ? 63 - i : i;
        const float gi = g_s[d * 64 + ni], bi = be_s[d * 64 + ni];
        float lv[4], av[4];
#pragma unroll
        for (int jj = 0; jj < 4; ++jj) { const int j = j4 + jj, nj = d ? 63 - j : j;
            const float e = __expf(fminf(gi - g_s[d * 64 + nj], 0.f));
            lv[jj] = (j < i) ? bi * KK[ni * 65 + nj] * e : 0.f; av[jj] = (j <= i) ? QK[ni * 65 + nj] * e : 0.f; }
        *(LAS f32x4*)(Ls + d * 4096 + i * 64 + j4) = (f32x4){lv[0], lv[1], lv[2], lv[3]};
        if (i >= 32 && j4 < 32) { v2u p; p.x = pk2(lv[0], lv[1]); p.y = pk2(lv[2], lv[3]); *(LAS v2u*)(L21i + d * 2560 + (i - 32) * 80 + j4 * 2) = p; }
        bf16* ag = (bf16*)(ws + WS_DNA) + ((size_t)d * 32 * 36 + ud) * 4096 + ni * 64;
        v2u q; if (d == 0) { q.x = pk2(av[0], av[1]); q.y = pk2(av[2], av[3]); *(v2u*)(ag + j4) = q; } else { q.x = pk2(av[3], av[2]); q.y = pk2(av[1], av[0]); *(v2u*)(ag + 60 - j4) = q; } }
    if (tid < 128) { const int d = tid >> 6, c = tid & 63; const float gl = g_s[d * 64 + (d ? 0 : 63)], gc = g_s[tid];
        float* vp = (float*)(ws + WS_DNVEC) + ((size_t)d * 32 * 36 + ud) * 256;
        vp[c] = expf(gc); vp[64 + c] = be_s[tid]; vp[128 + c] = expf(gl - gc); vp[192 + c] = expf(gl); }
    LDS_BARRIER();
    if (wave < 4) {
        const int d = wave >> 1, blk = wave & 1; int c = lane & 31; asm volatile("" : "+v"(c));
        const LAS float* Lb = Ls + d * 4096 + (blk * 32) * 64 + blk * 32;
        float t[32];
        f32x4 cur[8], nxt[8];
        cur[0] = *(const LAS f32x4*)(Lb + 1 * 64);
        t[0] = (c == 0) ? 1.0f : 0.0f;
#pragma unroll
        for (int i = 1; i < 32; ++i) {
            if (i + 1 < 32) {
#pragma unroll
                for (int j4 = 0; j4 < (i + 1 + 3) / 4; ++j4) nxt[j4] = *(const LAS f32x4*)(Lb + (i + 1) * 64 + j4 * 4);
            }
            float acc0 = (i == c) ? 1.0f : 0.0f, acc1 = 0.f, acc2 = 0.f, acc3 = 0.f;
#pragma unroll
            for (int j4 = 0; j4 < (i + 3) / 4; ++j4) {
                if (j4 * 4 + 0 < i) acc0 -= cur[j4].x * t[j4 * 4 + 0];
                if (j4 * 4 + 1 < i) acc1 -= cur[j4].y * t[j4 * 4 + 1];
                if (j4 * 4 + 2 < i) acc2 -= cur[j4].z * t[j4 * 4 + 2];
                if (j4 * 4 + 3 < i) acc3 -= cur[j4].w * t[j4 * 4 + 3]; }
            t[i] = (acc0 + acc1) + (acc2 + acc3);
#pragma unroll
            for (int j4 = 0; j4 < 8; ++j4) cur[j4] = nxt[j4];
        }
        if (lane < 32) {
            const int nc = d ? 63 - (blk * 32 + c) : blk * 32 + c;
#pragma unroll
            for (int i = 0; i < 32; ++i) { const int ni = d ? 63 - (blk * 32 + i) : blk * 32 + i; *(LAS bf16*)(Tn + d * 9216 + ni * 144 + nc * 2) = (bf16)f2bf(t[i]); }
            if (blk == 0) {
#pragma unroll
                for (int i = 0; i < 32; i += 2) *(LAS unsigned*)(T11T + d * 2560 + c * 80 + i * 2) = pk2(t[i], t[i + 1]);
            } else {
#pragma unroll
                for (int i = 0; i < 32; ++i) *(LAS bf16*)(T22i + d * 2560 + i * 80 + c * 2) = (bf16)f2bf(t[i]);
            }
        }
    }
    LDS_BARRIER();
    { const int d = wave >> 2, mt = (wave >> 1) & 1, nt = wave & 1;
      const f32x4 z4 = {0.f, 0.f, 0.f, 0.f};
      const f32x4 m = MFMA16(ldfrag(L21i + d * 2560, 80, mt * 16, 0, lane), ldfrag(T11T + d * 2560, 80, nt * 16, 0, lane), z4);
      v2u p; p.x = pk2(m[0], m[1]); p.y = pk2(m[2], m[3]);
      *(LAS v2u*)(MTi + d * 2560 + (nt * 16 + (lane & 15)) * 80 + (mt * 16 + (lane >> 4) * 4) * 2) = p; }
    LDS_BARRIER();
    { const int d = wave >> 2, mt = (wave >> 1) & 1, nt = wave & 1;
      const f32x4 z4 = {0.f, 0.f, 0.f, 0.f};
      const f32x4 m = MFMA16(ldfrag(T22i + d * 2560, 80, mt * 16, 0, lane), ldfrag(MTi + d * 2560, 80, nt * 16, 0, lane), z4);
      const int j = nt * 16 + (lane & 15), nj = d ? 63 - j : j;
#pragma unroll
      for (int ii = 0; ii < 4; ++ii) { const int i = 32 + mt * 16 + (lane >> 4) * 4 + ii, ni = d ? 63 - i : i; *(LAS bf16*)(Tn + d * 9216 + ni * 144 + nj * 2) = (bf16)f2bf(-m[ii]); } }
    LDS_BARRIER();
    for (int p = tid; p < 1024; p += NT) { const int d = p >> 9, q = p & 511, c = q >> 3, jj = (q & 7) * 8;
        ((v4u*)(ws + WS_DNT))[((size_t)d * 32 * 36 + ud) * 512 + q] = *(const LAS v4u*)(Tn + d * 9216 + c * 144 + jj * 2); }
}

DI void dn_chain_phase(const Args& a, LAS unsigned char* lds, int vcu, int G) {
    const int tid = tid_fresh(), lane = tid & 63, wave = __builtin_amdgcn_readfirstlane(tid >> 6);
    unsigned char* ws = a.ws;
    constexpr int BUF = 58368, O_Q = 0, O_K = 17408, O_T = 34816, O_A = 44032, O_V = 53248, O_VEC = 57344, O_ST = 2 * BUF, O_RT = O_ST + 8704, O_VN = O_RT + 4608, O_VW = O_VN + 4608;
    for (int u = vcu; u < 256; u += G) {
        const int b = u >> 5, h = (u >> 3) & 3, d = (u >> 2) & 1, sl = u & 3, bh = b * 4 + h;
        const bf16* Qg = (const bf16*)(ws + WS_DNQ) + h * 128; const bf16* Kg = (const bf16*)(ws + WS_DNK) + h * 128; const bf16* Vg = (const bf16*)(ws + WS_DNV) + h * 128 + sl * 32;
        const v4u* Tg = (const v4u*)(ws + WS_DNT) + ((size_t)d * 32 + bh) * 36 * 512; const v4u* Ag = (const v4u*)(ws + WS_DNA) + ((size_t)d * 32 + bh) * 36 * 512;
        const f32x4* Vecg = (const f32x4*)(ws + WS_DNVEC) + ((size_t)d * 32 + bh) * 36 * 64;
        bf16* Og = (bf16*)(ws + WS_DNO) + (size_t)d * M0 * 512 + h * 128 + sl * 32;
        f32x4 S0 = {0.f, 0.f, 0.f, 0.f}, S1 = S0;
        LDS_BARRIER();
        for (int i = tid; i < 8704 / 4; i += NT) ((LAS unsigned*)(lds + O_ST))[i] = 0u;
        v4u rq[2], rk[2], rt, ra, rv; f32x4 rvec;
#define chunk_of(n_) ((n_) < 4 ? (d ? 3 - (n_) : (n_)) : 4 + (d ? 31 - ((n_) - 4) : (n_) - 4))
#define DN_LOAD(n_) do { const int ck_ = chunk_of(n_); const size_t row0_ = ck_ < 4 ? (size_t)ML + b * CTXL + ck_ * 64 : (size_t)b * SEQ + (ck_ - 4) * 64; \
            { const int c_ = tid >> 4, kk_ = (tid & 15) * 8; rq[0] = *(const v4u*)(Qg + (row0_ + c_) * 512 + kk_); rq[1] = *(const v4u*)(Qg + (row0_ + c_ + 32) * 512 + kk_); \
              rk[0] = *(const v4u*)(Kg + (row0_ + c_) * 512 + kk_); rk[1] = *(const v4u*)(Kg + (row0_ + c_ + 32) * 512 + kk_); } \
            rt = Tg[(size_t)ck_ * 512 + tid]; ra = Ag[(size_t)ck_ * 512 + tid]; \
            if (tid < 256) rv = *(const v4u*)(Vg + (row0_ + (tid >> 2)) * 512 + (tid & 3) * 8); \
            if (tid < 64) rvec = Vecg[(size_t)ck_ * 64 + tid]; } while (0)
#define DN_STORE(SB_) do { { const int c_ = tid >> 4, kk_ = (tid & 15) * 8; *(LAS v4u*)((SB_) + O_Q + c_ * 272 + kk_ * 2) = rq[0]; *(LAS v4u*)((SB_) + O_Q + (c_ + 32) * 272 + kk_ * 2) = rq[1]; \
              *(LAS v4u*)((SB_) + O_K + c_ * 272 + kk_ * 2) = rk[0]; *(LAS v4u*)((SB_) + O_K + (c_ + 32) * 272 + kk_ * 2) = rk[1]; } \
            { const int c_ = tid >> 3, jj_ = (tid & 7) * 8; *(LAS v4u*)((SB_) + O_T + c_ * 144 + jj_ * 2) = rt; *(LAS v4u*)((SB_) + O_A + c_ * 144 + jj_ * 2) = ra; } \
            if (tid < 256) *(LAS v4u*)((SB_) + O_V + (tid >> 2) * 64 + (tid & 3) * 16) = rv; \
            if (tid < 64) *(LAS f32x4*)((SB_) + O_VEC + tid * 16) = rvec; } while (0)
        DN_LOAD(0); DN_STORE(lds); DN_LOAD(1);
        LDS_BARRIER();
        for (int n = 0; n < 36; ++n) {
            LAS unsigned char* B = lds + (n & 1) * BUF;
            if (n + 1 < 36) { DN_STORE(lds + ((n + 1) & 1) * BUF); if (n + 2 < 36) DN_LOAD(n + 2); }
            const int ck = chunk_of(n); const size_t row0 = ck < 4 ? (size_t)ML + b * CTXL + ck * 64 : (size_t)b * SEQ + (ck - 4) * 64;
            const int mt = wave >> 1, nt = wave & 1;
            const LAS float* vec = (const LAS float*)(B + O_VEC);
            const int cb = mt * 16 + (lane >> 4) * 4, vv = nt * 16 + (lane & 15);
            f32x4 ksa = {0.f, 0.f, 0.f, 0.f}, qsa = ksa;
#pragma unroll
            for (int ks = 0; ks < 4; ++ks) { const bf16x8 fk = ldfrag(B + O_K, 272, mt * 16, ks * 32, lane), fq = ldfrag(B + O_Q, 272, mt * 16, ks * 32, lane), fs = ldfrag(lds + O_ST, 272, nt * 16, ks * 32, lane);
                ksa = MFMA16(fk, fs, ksa); qsa = MFMA16(fq, fs, qsa); }
            {
                const f32x4 eg = *(const LAS f32x4*)(vec + cb), be = *(const LAS f32x4*)(vec + 64 + cb);
                float rr[4];
#pragma unroll
                for (int i = 0; i < 4; ++i) { const float vval = bf2f(*(const LAS bf16*)(B + O_V + (cb + i) * 64 + vv * 2)); rr[i] = be[i] * (vval - eg[i] * ksa[i]); qsa[i] *= eg[i]; }
                v2u p; p.x = pk2(rr[0], rr[1]); p.y = pk2(rr[2], rr[3]);
                *(LAS v2u*)(lds + O_RT + vv * 144 + cb * 2) = p;
            }
            LDS_BARRIER();
            {
                f32x4 vn = {0.f, 0.f, 0.f, 0.f};
#pragma unroll
                for (int ks = 0; ks < 2; ++ks) { const bf16x8 ft = ldfrag(B + O_T, 144, mt * 16, ks * 32, lane), fr = ldfrag(lds + O_RT, 144, nt * 16, ks * 32, lane); vn = MFMA16(ft, fr, vn); }
                const f32x4 w = *(const LAS f32x4*)(vec + 128 + cb);
                v2u p, q; p.x = pk2(vn[0], vn[1]); p.y = pk2(vn[2], vn[3]); q.x = pk2(vn[0] * w[0], vn[1] * w[1]); q.y = pk2(vn[2] * w[2], vn[3] * w[3]);
                *(LAS v2u*)(lds + O_VN + vv * 144 + cb * 2) = p; *(LAS v2u*)(lds + O_VW + vv * 144 + cb * 2) = q;
            }
            LDS_BARRIER();
            {
#pragma unroll
                for (int ks = 0; ks < 2; ++ks) { const bf16x8 fa = ldfrag(B + O_A, 144, mt * 16, ks * 32, lane), fv = ldfrag(lds + O_VN, 144, nt * 16, ks * 32, lane); qsa = MFMA16(fa, fv, qsa); }
#pragma unroll
                for (int i = 0; i < 4; ++i) Og[(row0 + cb + i) * 512 + vv] = (bf16)f2bf(qsa[i]);
                const float gt = vec[192];
                S0 = S0 * gt; S1 = S1 * gt;
#pragma unroll
                for (int ks = 0; ks < 2; ++ks) { const bf16x8 fkt = ldfrag_tr(B + O_K, 272, ks * 32, wave * 16, lane), fw0 = ldfrag(lds + O_VW, 144, 0, ks * 32, lane), fw1 = ldfrag(lds + O_VW, 144, 16, ks * 32, lane);
                    S0 = MFMA16(fkt, fw0, S0); S1 = MFMA16(fkt, fw1, S1); }
                v2u p0, p1; p0.x = pk2(S0[0], S0[1]); p0.y = pk2(S0[2], S0[3]); p1.x = pk2(S1[0], S1[1]); p1.y = pk2(S1[2], S1[3]);
                const int kb = wave * 16 + (lane >> 4) * 4;
                *(LAS v2u*)(lds + O_ST + (lane & 15) * 272 + kb * 2) = p0; *(LAS v2u*)(lds + O_ST + (16 + (lane & 15)) * 272 + kb * 2) = p1;
            }
            LDS_BARRIER();
        }
#undef chunk_of
#undef DN_LOAD
#undef DN_STORE
    }
}

template <bool FINAL> DI void rg_phase(const Args& a, LAS unsigned char* lds, int vcu0, int G) {
    const int vcu = FINAL ? vcu0 : (vcu0 + G / 2) % G;
    const int tid = tid_fresh(), lane = tid & 63, wave = __builtin_amdgcn_readfirstlane(tid >> 6);
    unsigned char* ws = a.ws;
    const bf16* U = (const bf16*)(ws + WS_U);
    float* SUM = (float*)(ws + WS_RGSUM);
    LAS unsigned char* UAs = lds;
    LAS float* scr = (LAS float*)(lds + 33280 + wave * 8192);
    LAS float* carry_s = (LAS float*)(lds + 33280 + 65536);
    const int cp = (tid & 255) * 2, hf = tid >> 8;
    float cwv[4][2];
#pragma unroll
    for (int j = 0; j < 4; ++j) { cwv[j][0] = a.in[I_ACONVW][j * 512 + cp]; cwv[j][1] = a.in[I_ACONVW][j * 512 + cp + 1]; }
    const float cb0 = a.in[I_ACONVB][cp], cb1 = a.in[I_ACONVB][cp + 1];
    const int blk = wave, cl = lane & 15, q4 = (lane >> 4) * 4;
    float gbr[2][4], gbi[2][4], c1[2][4];
#pragma unroll
    for (int d = 0; d < 2; ++d)
#pragma unroll
        for (int nt = 0; nt < 4; ++nt) { const int ch = blk * 64 + nt * 16 + cl;
            gbr[d][nt] = -1.4426950408889634f * a.in[I_AGATEB][(d * 2 + 0) * 512 + ch]; gbi[d][nt] = -1.4426950408889634f * a.in[I_AGATEB][(d * 2 + 1) * 512 + ch];
            c1[d][nt] = -8.0f * 1.4426950408889634f * softplus_(-a.in[I_ALAM][d * 512 + ch]); }
    const bf16* GWT = (const bf16*)(ws + WS_GWT);
    unsigned xs[19]; float cpre0 = 0.f, cpre1 = 0.f;
#define RG_FETCH(u_) do { const int b_ = (u_) / 72, ck_ = (u_) - b_ * 72; const int row0_ = ck_ < 8 ? ML + b_ * CTXL + ck_ * 32 : b_ * SEQ + (ck_ - 8) * 32, seg0_ = ck_ < 8 ? ML + b_ * CTXL : b_ * SEQ, len_ = ck_ < 8 ? CTXL : SEQ, t0_ = row0_ - seg0_; \
        _Pragma("unroll") for (int i_ = 0; i_ < 19; ++i_) { const int tt_ = t0_ + hf * 16 + i_ - 2; xs[i_] = (tt_ >= 0 && tt_ < len_) ? *(const unsigned*)(U + (size_t)(seg0_ + tt_) * NU0S + cp) : 0u; } \
        if (FINAL) { const float* cg_ = (const float*)(ws + WS_RGCARRY) + ((size_t)b_ * 72 + ck_) * 1024; cpre0 = cg_[tid]; cpre1 = cg_[tid + 512]; } } while (0)
    int u = vcu;
    if (u < 576) RG_FETCH(u);
    for (; u < 576; u += G) {
        const int b = u / 72, ck = u - b * 72;
        const int row0 = ck < 8 ? ML + b * CTXL + ck * 32 : b * SEQ + (ck - 8) * 32;
        LDS_BARRIER();
#pragma unroll
        for (int i = 0; i < 16; ++i) { float a0 = cb0, a1 = cb1;
#pragma unroll
            for (int j = 0; j < 4; ++j) { a0 += cwv[j][0] * bflo(xs[i + j]); a1 += cwv[j][1] * bfhi(xs[i + j]); }
            *(LAS unsigned*)(UAs + (hf * 16 + i) * 1040 + cp * 2) = pk2(a0, a1); }
        if (FINAL) { carry_s[tid] = cpre0; carry_s[tid + 512] = cpre1; }
        if (u + G < 576) RG_FETCH(u + G);
        LDS_BARRIER();
        bf16x8 fa[2][2];
#pragma unroll
        for (int mt = 0; mt < 2; ++mt)
#pragma unroll
            for (int ks = 0; ks < 2; ++ks) fa[mt][ks] = ldfrag(UAs, 1040, mt * 16, blk * 64 + ks * 32, lane);
        bf16x8 wf[2][2][2];
#define RG_LOADW(nt_) do { _Pragma("unroll") for (int d_ = 0; d_ < 2; ++d_) _Pragma("unroll") for (int g_ = 0; g_ < 2; ++g_) _Pragma("unroll") for (int ks_ = 0; ks_ < 2; ++ks_) \
            wf[d_][g_][ks_] = *(const bf16x8*)(GWT + (size_t)((d_ * 2 + g_) * 8 + blk) * 4096 + ((nt_) * 16 + cl) * 64 + ks_ * 32 + (lane >> 4) * 8); } while (0)
        RG_LOADW(0);
#pragma unroll 1
        for (int nt = 0; nt < 4; ++nt) {
            bf16 ayv[8];
            if (FINAL) {
#pragma unroll
                for (int e = 0; e < 8; ++e) { const int idx = e * 64 + lane; ayv[e] = U[(size_t)(row0 + (idx >> 4)) * NU0S + 512 + blk * 64 + nt * 16 + (idx & 15)]; } }
            bf16x8 wn[2][2];
#pragma unroll
            for (int g_ = 0; g_ < 2; ++g_)
#pragma unroll
                for (int ks_ = 0; ks_ < 2; ++ks_) wn[g_][ks_] = wf[1][g_][ks_];
#pragma unroll
            for (int d = 0; d < 2; ++d) {
                const float gbr_ = nt == 0 ? gbr[d][0] : (nt == 1 ? gbr[d][1] : (nt == 2 ? gbr[d][2] : gbr[d][3]));
                const float gbi_ = nt == 0 ? gbi[d][0] : (nt == 1 ? gbi[d][1] : (nt == 2 ? gbi[d][2] : gbi[d][3]));
                const float c1_ = nt == 0 ? c1[d][0] : (nt == 1 ? c1[d][1] : (nt == 2 ? c1[d][2] : c1[d][3]));
                f32x4 ar[2], ai[2];
#pragma unroll
                for (int mt = 0; mt < 2; ++mt) { ar[mt] = (f32x4){0.f, 0.f, 0.f, 0.f}; ai[mt] = ar[mt];
#pragma unroll
                    for (int ks = 0; ks < 2; ++ks) { ar[mt] = MFMA16(fa[mt][ks], d ? wn[0][ks] : wf[0][0][ks], ar[mt]); ai[mt] = MFMA16(fa[mt][ks], d ? wn[1][ks] : wf[0][1][ks], ai[mt]); } }
                if (d == 1 && nt < 3) RG_LOADW(nt + 1);
                float av8[2][4], xv8[2][4];
#pragma unroll
                for (int mt = 0; mt < 2; ++mt)
#pragma unroll
                    for (int i = 0; i < 4; ++i) { const int c = mt * 16 + q4 + i;
                        const float rr = frcp(1.0f + __builtin_amdgcn_exp2f(ar[mt][i] * -1.4426950408889634f + gbr_));
                        const float ig = frcp(1.0f + __builtin_amdgcn_exp2f(ai[mt][i] * -1.4426950408889634f + gbi_));
                        const float av = __builtin_amdgcn_exp2f(c1_ * rr), ua = bf2f(*(const LAS bf16*)(UAs + c * 1040 + (blk * 64 + nt * 16 + cl) * 2));
                        const float xv = __builtin_amdgcn_sqrtf(fmaxf(1.0f - av * av, 0.f)) * (ig * ua);
                        av8[mt][i] = av; xv8[mt][i] = xv;
                        if (FINAL) { scr[((d * 2 + 0) * 32 + c) * 16 + cl] = av; scr[((d * 2 + 1) * 32 + c) * 16 + cl] = xv; }
                        if (!FINAL) ((unsigned*)(ws + WS_RGAX))[((size_t)d * M0 + row0 + c) * 512 + blk * 64 + nt * 16 + cl] = (unsigned)__builtin_bit_cast(unsigned short, (_Float16)(1.0f - av)) | ((unsigned)__builtin_bit_cast(unsigned short, (_Float16)xv) << 16); }
                if (!FINAL) {
                    float P[2], H[2];
#pragma unroll
                    for (int mt = 0; mt < 2; ++mt) { float p = 1.f, hh = 0.f;
#pragma unroll
                        for (int s = 0; s < 4; ++s) { const int i = d ? 3 - s : s; hh = av8[mt][i] * hh + xv8[mt][i]; p *= av8[mt][i]; }
#pragma unroll
                        for (int st = 0; st < 2; ++st) { const int bit = st ? 2 : 1; const float po = __shfl_xor(p, 16 * bit), ho = __shfl_xor(hh, 16 * bit);
                            const bool mine_first = (((lane >> 4) & bit) == 0) != (d == 1);
                            const float pe = mine_first ? p : po, he = mine_first ? hh : ho, pl = mine_first ? po : p, hl = mine_first ? ho : hh;
                            p = pl * pe; hh = pl * he + hl; }
                        P[mt] = p; H[mt] = hh; }
                    const float pe = d ? P[1] : P[0], he = d ? H[1] : H[0], pl = d ? P[0] : P[1], hl = d ? H[0] : H[1];
                    if (lane < 16) { float* sp = SUM + ((size_t)(d * 8 + b) * 72 + ck) * 1024 + (blk * 64 + nt * 16 + cl) * 2; sp[0] = pl * pe; sp[1] = pl * he + hl; }
                }
            }
            if (!FINAL) continue;
            __builtin_amdgcn_wave_barrier(); LDS_WAIT();
            if (lane < 32) { const int d = lane >> 4, chh = blk * 64 + nt * 16 + cl;
                float hh = FINAL ? carry_s[d * 512 + chh] : 0.f, P = 1.f;
#pragma unroll 8
                for (int s = 0; s < 32; ++s) { const int c = d ? 31 - s : s; const float av = scr[((d * 2 + 0) * 32 + c) * 16 + cl], xv = scr[((d * 2 + 1) * 32 + c) * 16 + cl];
                    hh = av * hh + xv; if (FINAL) scr[((d * 2 + 1) * 32 + c) * 16 + cl] = hh; else P *= av; }
                if (!FINAL) { float* sp = SUM + ((size_t)(d * 8 + b) * 72 + ck) * 1024 + chh * 2; sp[0] = P; sp[1] = hh; } }
            __builtin_amdgcn_wave_barrier(); LDS_WAIT();
            if (FINAL) {
                bf16* Y = (bf16*)(ws + WS_Y);
#pragma unroll
                for (int e = 0; e < 8; ++e) { const int idx = e * 64 + lane, c = idx >> 4, c2 = idx & 15, chh = blk * 64 + nt * 16 + c2;
                    const float hs = scr[((0 * 2 + 1) * 32 + c) * 16 + c2] + scr[((1 * 2 + 1) * 32 + c) * 16 + c2];
                    Y[(size_t)(row0 + c) * D + chh] = (bf16)f2bf(hs * gelu_tanh(bf2f(ayv[e]))); }
            }
            __builtin_amdgcn_wave_barrier(); LDS_WAIT();
        }
#undef RG_LOADW
    }
#undef RG_FETCH
}

DI void rg_carry_phase(const Args& a, int vcu, int G) {
    const int tid = tid_fresh();
    unsigned char* ws = a.ws;
    const float* SUM = (const float*)(ws + WS_RGSUM); float* CARRY = (float*)(ws + WS_RGCARRY);
    if (tid >= 64) return;
    for (int cidx = vcu * 64 + tid; cidx < 8192; cidx += G * 64) {
        const int ch = cidx & 511, d = (cidx >> 9) & 1, b = cidx >> 10;
        const float* sp = SUM + (size_t)(d * 8 + b) * 72 * 1024 + ch * 2;
        float* cp = CARRY + (size_t)b * 72 * 1024 + d * 512 + ch;
        float carry = 0.f;
#pragma unroll 1
        for (int p0 = 0; p0 < 72; p0 += 12) {
            typedef float f32x2_ __attribute__((ext_vector_type(2)));
            f32x2_ ph[12]; int ee[12];
#pragma unroll
            for (int q = 0; q < 12; ++q) { const int p = p0 + q; ee[q] = d == 0 ? p : (p < 8 ? 7 - p : 71 - (p - 8)); ph[q] = *(const f32x2_*)(sp + ee[q] * 1024); }
#pragma unroll
            for (int q = 0; q < 12; ++q) { cp[(size_t)ee[q] * 1024] = carry; carry = ph[q].x * carry + ph[q].y; }
        }
    }
}

DI void rg_final_phase(const Args& a, int vcu, int G) {
    const int tid = tid_fresh();
    unsigned char* ws = a.ws;
    const bf16* U = (const bf16*)(ws + WS_U); bf16* Y = (bf16*)(ws + WS_Y);
    const unsigned* AX0 = (const unsigned*)(ws + WS_RGAX); const unsigned* AX1 = AX0 + (size_t)M0 * 512;
    for (int u = vcu; u < 576; u += G) {
        const int b = u / 72, ck = u - b * 72;
        const size_t row0 = ck < 8 ? (size_t)ML + b * CTXL + ck * 32 : (size_t)b * SEQ + (ck - 8) * 32;
        const float* cg = (const float*)(ws + WS_RGCARRY) + ((size_t)b * 72 + ck) * 1024;
        float h0 = cg[tid], h1 = cg[512 + tid];
        unsigned w0[32], w1[32]; bf16 ay[32];
#pragma unroll
        for (int c = 0; c < 32; ++c) { w0[c] = AX0[(row0 + c) * 512 + tid]; w1[c] = AX1[(row0 + c) * 512 + tid]; ay[c] = U[(row0 + c) * NU0S + 512 + tid]; }
        float hf[32];
#pragma unroll
        for (int c = 0; c < 32; ++c) { const float om = (float)__builtin_bit_cast(_Float16, (unsigned short)(w0[c] & 0xffff)), xv = (float)__builtin_bit_cast(_Float16, (unsigned short)(w0[c] >> 16)); h0 = (h0 - om * h0) + xv; hf[c] = h0; }
#pragma unroll
        for (int c = 31; c >= 0; --c) { const float om = (float)__builtin_bit_cast(_Float16, (unsigned short)(w1[c] & 0xffff)), xv = (float)__builtin_bit_cast(_Float16, (unsigned short)(w1[c] >> 16)); h1 = (h1 - om * h1) + xv;
            Y[(row0 + c) * D + tid] = (bf16)f2bf((hf[c] + h1) * gelu_tanh(bf2f(ay[c]))); }
    }
}


DI void merge0_phase(const Args& a, int vcu, int G) {
    const int tid = tid_fresh(), lane = tid & 63, wave = __builtin_amdgcn_readfirstlane(tid >> 6);
    const int heavy = 0;
    if (vcu < heavy) return;
    const int gw = (vcu - heavy) * NWAVES + wave, NGW = (G - heavy) * NWAVES;
    unsigned char* ws = a.ws;
    const bf16* U = (const bf16*)(ws + WS_U); bf16* Y = (bf16*)(ws + WS_Y);
    const bf16* O0 = (const bf16*)(ws + WS_DNO); const bf16* O1 = O0 + (size_t)M0 * 512;
    const int c0 = 8 * lane;
    float ng[8];
#pragma unroll
    for (int i = 0; i < 8; ++i) ng[i] = a.in[I_BNORMG][(c0 & 127) + i];
    for (int r = gw; r < M0; r += NGW) {
        const size_t o = (size_t)r * 512 + c0;
        const v4u x0 = *(const v4u*)(O0 + o), x1 = *(const v4u*)(O1 + o);
        const f32x4 oa = {bflo(x0.x) + bflo(x1.x), bfhi(x0.x) + bfhi(x1.x), bflo(x0.y) + bflo(x1.y), bfhi(x0.y) + bfhi(x1.y)}, ob = {bflo(x0.z) + bflo(x1.z), bfhi(x0.z) + bfhi(x1.z), bflo(x0.w) + bflo(x1.w), bfhi(x0.w) + bfhi(x1.w)};
        float ss = (oa.x * oa.x + oa.y * oa.y) + (oa.z * oa.z + oa.w * oa.w) + (ob.x * ob.x + ob.y * ob.y) + (ob.z * ob.z + ob.w * ob.w);
        ss = sum16(ss);
        const float rs = rsqrtf(ss * (1.0f / 128.0f) + EPS);
        const v4u z = *(const v4u*)(U + (size_t)r * NU0S + 2560 + c0);
        v4u y;
        y.x = pk2(oa.x * rs * ng[0] * silu_(bflo(z.x)), oa.y * rs * ng[1] * silu_(bfhi(z.x))); y.y = pk2(oa.z * rs * ng[2] * silu_(bflo(z.y)), oa.w * rs * ng[3] * silu_(bfhi(z.y)));
        y.z = pk2(ob.x * rs * ng[4] * silu_(bflo(z.z)), ob.y * rs * ng[5] * silu_(bfhi(z.z))); y.w = pk2(ob.z * rs * ng[6] * silu_(bflo(z.w)), ob.w * rs * ng[7] * silu_(bfhi(z.w)));
        *(v4u*)(Y + (size_t)r * D + 512 + c0) = y;
    }
}

DI void merge1_phase(const Args& a, int vcu, int G) {
    const int tid = tid_fresh(), lane = tid & 63, wave = __builtin_amdgcn_readfirstlane(tid >> 6);
    const int gw = vcu * NWAVES + wave, NGW = G * NWAVES;
    unsigned char* ws = a.ws;
    const bf16* U = (const bf16*)(ws + WS_U); bf16* Y = (bf16*)(ws + WS_Y);
    const bf16* O0 = (const bf16*)(ws + WS_O1); const bf16* O1 = O0 + (size_t)ML * 1024;
    const int c0 = 16 * lane;
    const float* ngp = c0 < 512 ? a.in[I_CNORMG] : a.in[I_DNORMG];
    const int gcol = c0 < 512 ? 2048 + c0 : 3584 + (c0 - 512);
    float ng[16];
#pragma unroll
    for (int i = 0; i < 16; ++i) ng[i] = ngp[(c0 & 127) + i];
    for (int r = gw; r < ML; r += NGW) {
        float o[16]; float ss = 0.f;
#pragma unroll
        for (int hh = 0; hh < 2; ++hh) { const v4u x0 = *(const v4u*)(O0 + (size_t)r * 1024 + c0 + 8 * hh), x1 = *(const v4u*)(O1 + (size_t)r * 1024 + c0 + 8 * hh);
            o[8 * hh + 0] = bflo(x0.x) + bflo(x1.x); o[8 * hh + 1] = bfhi(x0.x) + bfhi(x1.x); o[8 * hh + 2] = bflo(x0.y) + bflo(x1.y); o[8 * hh + 3] = bfhi(x0.y) + bfhi(x1.y);
            o[8 * hh + 4] = bflo(x0.z) + bflo(x1.z); o[8 * hh + 5] = bfhi(x0.z) + bfhi(x1.z); o[8 * hh + 6] = bflo(x0.w) + bflo(x1.w); o[8 * hh + 7] = bfhi(x0.w) + bfhi(x1.w); }
#pragma unroll
        for (int i = 0; i < 16; ++i) ss += o[i] * o[i];
        ss = sum8(ss);
        const float rs = rsqrtf(ss * (1.0f / 128.0f) + EPS);
#pragma unroll
        for (int hh = 0; hh < 2; ++hh) { const v4u z = *(const v4u*)(U + (size_t)r * NU1S + gcol + 8 * hh); const float* oo = o + 8 * hh; const float* gg = ng + 8 * hh;
            v4u y;
            y.x = pk2(oo[0] * rs * gg[0] * silu_(bflo(z.x)), oo[1] * rs * gg[1] * silu_(bfhi(z.x))); y.y = pk2(oo[2] * rs * gg[2] * silu_(bflo(z.y)), oo[3] * rs * gg[3] * silu_(bfhi(z.y)));
            y.z = pk2(oo[4] * rs * gg[4] * silu_(bflo(z.z)), oo[5] * rs * gg[5] * silu_(bfhi(z.z))); y.w = pk2(oo[6] * rs * gg[6] * silu_(bflo(z.w)), oo[7] * rs * gg[7] * silu_(bfhi(z.w)));
            *(v4u*)(Y + (size_t)r * D + c0 + 8 * hh) = y; }
    }
}

DI void moe_offsets(const unsigned* ctl, int (&off)[NEXP + 1]) {
    off[0] = 0;
#pragma unroll
    for (int e = 0; e < NEXP; ++e) { const unsigned c = __hip_atomic_load(ctl + CW_CNT + 64 * e, RLX_AGENT); off[e + 1] = off[e] + (int)((c + 255u) & ~255u); }
}
DI void moe_sort_phase(const Args& a, int vcu, int G) {
    const int tid = tid_fresh(), lane = tid & 63, wave = __builtin_amdgcn_readfirstlane(tid >> 6);
    const int gw = vcu * NWAVES + wave, NGW = G * NWAVES;
    unsigned char* ws = a.ws;
    unsigned* ctl = (unsigned*)(ws + WS_CTL);
    int off[NEXP + 1]; moe_offsets(ctl, off);
    if (blockIdx.x == 0 && tid < 160) {
        const int nt = off[NEXP] >> 8; int e = 0;
#pragma unroll
        for (int q = 1; q < NEXP; ++q) e += (tid * 256 >= off[q]) ? 1 : 0;
        ctl[CW_TILE_E + tid] = (unsigned)(tid < nt ? e : 0);
        if (tid == 0) { ctl[CW_NTILES] = (unsigned)nt;
            const int U4 = nt * 4, Gn = (int)gridDim.x; int F = (U4 / Gn) * Gn; const int R = U4 - F; int S = 1; if (R > 0 && R <= 32 && Gn >= 8 * R) S = 8; else if (R > 0 && R <= 64 && Gn >= 4 * R) S = 4; if (S == 1) F = U4;
#ifdef FORCE_S
            S = 1; F = U4; if (FORCE_S > 1 && R > 0 && R <= (FORCE_S == 8 ? 32 : 64)) { S = FORCE_S; F = (U4 / Gn) * Gn; }
#endif
            ctl[CW_TAILF] = (unsigned)F; ctl[CW_TAILS] = (unsigned)S; }
    }
    const bf16* XN2 = (const bf16*)(ws + WS_XN2); bf16* XS = (bf16*)(ws + WS_XS);
    for (int t = gw; t < ML; t += NGW) {
        unsigned* tk = (unsigned*)(ws + WS_TOPK) + (size_t)t * 8;
        const int e0 = (int)tk[0], e1 = (int)tk[1];
        int o0 = 0, o1 = 0;
#pragma unroll
        for (int q = 0; q < NEXP; ++q) { o0 = (e0 == q) ? off[q] : o0; o1 = (e1 == q) ? off[q] : o1; }
        const int p0 = o0 + (int)tk[4], p1 = o1 + (int)tk[5];
        const v4u x0 = *(const v4u*)(XN2 + (size_t)t * D + 8 * lane), x1 = *(const v4u*)(XN2 + (size_t)t * D + 512 + 8 * lane);
        *(v4u*)(XS + (size_t)p0 * D + 8 * lane) = x0; *(v4u*)(XS + (size_t)p0 * D + 512 + 8 * lane) = x1;
        *(v4u*)(XS + (size_t)p1 * D + 8 * lane) = x0; *(v4u*)(XS + (size_t)p1 * D + 512 + 8 * lane) = x1;
        if (lane == 0) { tk[6] = (unsigned)p0; tk[7] = (unsigned)p1; }
    }
}
DI void final_phase(const Args& a, int vcu, int G) {
    const int tid = tid_fresh(), lane = tid & 63, wave = __builtin_amdgcn_readfirstlane(tid >> 6);
    const int gw = vcu * NWAVES + wave, NGW = G * NWAVES;
    unsigned char* ws = a.ws;
    const bf16* OUTS = (const bf16*)(ws + WS_OUTS); const float* MOD = (const float*)(ws + WS_MOD);
    const unsigned* ctl = (const unsigned*)(ws + WS_CTL);
    const int tS = (int)__hip_atomic_load(ctl + CW_TAILS, RLX_AGENT), tail_row0 = tS > 1 ? ((int)__hip_atomic_load(ctl + CW_TAILF, RLX_AGENT) / 4) * 256 : 0x7fffffff;
    f32x4 fg[4];
#pragma unroll
    for (int j = 0; j < 4; ++j) fg[j] = *(const f32x4*)(a.in[I_FINALG] + 4 * lane + 256 * j);
    for (int tb = gw; tb < ML; tb += 2 * NGW) {
        f32x4 v[2][4]; float ss[2] = {0.f, 0.f};
#pragma unroll
        for (int q = 0; q < 2; ++q) { const int t = tb + q * NGW;
            if (t < ML) {
                const unsigned* tk = (const unsigned*)(ws + WS_TOPK) + (size_t)t * 8;
                const float p0 = __builtin_bit_cast(float, tk[2]), p1 = __builtin_bit_cast(float, tk[3]); const int r0 = (int)tk[6], r1 = (int)tk[7];
                const float* gate = MOD + (size_t)(9 + (t >> 11)) * 6144 + 5 * 1024;
                const float* hp = a.out + (size_t)t * D;
                f32x4 y0[4], y1[4];
                if (__builtin_amdgcn_readfirstlane(r0) >= tail_row0) {
#pragma unroll
                    for (int j = 0; j < 4; ++j) y0[j] = (f32x4){0.f, 0.f, 0.f, 0.f};
                    for (int s = 0; s < tS; ++s) { const float* pb = pg8::moe_part_base(ws, s, tS) + (size_t)(r0 - tail_row0) * D + 4 * lane;
#pragma unroll
                        for (int j = 0; j < 4; ++j) y0[j] += *(const f32x4*)(pb + 256 * j); }
#pragma unroll
                    for (int j = 0; j < 4; ++j) { const unsigned w0 = pk2(y0[j].x, y0[j].y), w1 = pk2(y0[j].z, y0[j].w); y0[j] = (f32x4){bflo(w0), bfhi(w0), bflo(w1), bfhi(w1)}; }
                } else {
#pragma unroll
                    for (int j = 0; j < 4; ++j) { const v2u x = *(const v2u*)(OUTS + (size_t)r0 * D + 4 * lane + 256 * j); y0[j] = (f32x4){bflo(x.x), bfhi(x.x), bflo(x.y), bfhi(x.y)}; } }
                if (__builtin_amdgcn_readfirstlane(r1) >= tail_row0) {
#pragma unroll
                    for (int j = 0; j < 4; ++j) y1[j] = (f32x4){0.f, 0.f, 0.f, 0.f};
                    for (int s = 0; s < tS; ++s) { const float* pb = pg8::moe_part_base(ws, s, tS) + (size_t)(r1 - tail_row0) * D + 4 * lane;
#pragma unroll
                        for (int j = 0; j < 4; ++j) y1[j] += *(const f32x4*)(pb + 256 * j); }
#pragma unroll
                    for (int j = 0; j < 4; ++j) { const unsigned w0 = pk2(y1[j].x, y1[j].y), w1 = pk2(y1[j].z, y1[j].w); y1[j] = (f32x4){bflo(w0), bfhi(w0), bflo(w1), bfhi(w1)}; }
                } else {
#pragma unroll
                    for (int j = 0; j < 4; ++j) { const v2u x = *(const v2u*)(OUTS + (size_t)r1 * D + 4 * lane + 256 * j); y1[j] = (f32x4){bflo(x.x), bfhi(x.x), bflo(x.y), bfhi(x.y)}; } }
#pragma unroll
                for (int j = 0; j < 4; ++j) { const int k = 4 * lane + 256 * j;
                    v[q][j] = *(const f32x4*)(hp + k) + *(const f32x4*)(gate + k) * (y0[j] * p0 + y1[j] * p1);
                    ss[q] += (v[q][j].x * v[q][j].x + v[q][j].y * v[q][j].y) + (v[q][j].z * v[q][j].z + v[q][j].w * v[q][j].w); }
            } }
#pragma unroll
        for (int q = 0; q < 2; ++q) ss[q] = wave_sum(ss[q]);
#pragma unroll
        for (int q = 0; q < 2; ++q) { const int t = tb + q * NGW;
            if (t < ML) { const float rstd = rsqrtf(ss[q] * (1.0f / D) + EPS); float* hp = a.out + (size_t)t * D;
#pragma unroll
                for (int j = 0; j < 4; ++j) *(f32x4*)(hp + 4 * lane + 256 * j) = v[q][j] * rstd * fg[j]; } }
    }
}

constexpr int RING_BYTES = 153600, MISC_OFF = RING_BYTES, LDS_BYTES = RING_BYTES + 512;
enum { PH_PRO = 0, PH_NORM0, PH_GIN0, PH_PREP0, PH_SCAN0, PH_MERGE0, PH_GOUT0, PH_NORMF0, PH_GGU0, PH_GDN0, PH_NORM1, PH_GIN1, PH_PREP1, PH_CHAIN1, PH_MERGE1, PH_GOUT1, PH_NORMF1, PH_SORT, PH_MGU, PH_MDN, PH_FINAL, NPHASE };
__global__ void __launch_bounds__(NT, 2) mk_fwd(Args a) {
    extern __shared__ __attribute__((aligned(16))) unsigned char lds_raw[];
    LAS unsigned char* lds = (LAS unsigned char*)lds_raw;
    const int tid = tid_fresh();
    const int G = gridDim.x, bx = blockIdx.x, vcu = (G % 8 == 0) ? (bx % 8) * (G / 8) + bx / 8 : bx;
    unsigned char* ws = a.ws;
    volatile LAS unsigned* MISC = (volatile LAS unsigned*)(lds + MISC_OFF);
    for (int u = tid; u < (LDS_BYTES - RING_BYTES) / 4; u += NT) ((LAS unsigned*)(lds + RING_BYTES))[u] = 0u;
    __syncthreads();
    const int lo = a.ph_lo, hi = a.ph_hi;
    XcdBarrier bar; bar.bar = (unsigned*)(ws + WS_CTL) + CW_BAR; bar.x = 0; bar.st = nullptr;
    if (hi - lo > 1) bar = xcd_barrier_post((unsigned*)(ws + WS_CTL) + CW_BAR, MISC + 8);
#define IN(k) (lo <= (k) && (k) < hi)
#if defined(SUBP) && SUBP == 9
#define SEAM(k) do { if (IN(k) && IN((k) + 1)) { xcd_barrier(bar); xcd_barrier(bar); } } while (0)
#else
#define SEAM(k) do { if (IN(k) && IN((k) + 1)) xcd_barrier(bar); } while (0)
#endif
#ifndef REP_MASK
#define REP_MASK 0u
#endif
#define REPS(k) (((REP_MASK >> (k)) & 1u) ? 2 : 1)
    using namespace pg8;
    if (IN(PH_PRO)) for (int rep_ = 0; rep_ < REPS(PH_PRO); ++rep_) { if (rep_) __syncthreads(); p0_prologue(a, lds, vcu, G); } SEAM(PH_PRO);
    if (IN(PH_NORM0)) for (int rep_ = 0; rep_ < REPS(PH_NORM0); ++rep_) { if (rep_) __syncthreads(); norm_phase<0>(a, lds, vcu, G); } SEAM(PH_NORM0);
    if (IN(PH_GIN0)) for (int rep_ = 0; rep_ < REPS(PH_GIN0); ++rep_) { if (rep_) __syncthreads(); Gemm g{(const bf16_t*)(ws + WS_XN), (const bf16_t*)(ws + WS_WIN0), 1024}; StaticOrder S; S.init(M0, NU0S, G, bx); EpiBf16 E{(bf16_t*)(ws + WS_U), NU0S};
        gemm_phase<EpiBf16, StaticOrder, true, true>(lds, g, S, E); } SEAM(PH_GIN0);
    if (IN(PH_PREP0)) for (int rep_ = 0; rep_ < REPS(PH_PREP0); ++rep_) { if (rep_) __syncthreads(); for (int u = vcu; u < 1152; u += G) dn_prep_unit(a, lds, u); rg_phase<false>(a, lds, vcu, G);
#if defined(SUBP) && SUBP == 1
        for (int u = vcu; u < 1152; u += G) dn_prep_unit(a, lds, u);
#endif
#if defined(SUBP) && SUBP == 6
        rg_phase<false>(a, lds, vcu, G);
#endif
        } SEAM(PH_PREP0);
    if (IN(PH_SCAN0)) for (int rep_ = 0; rep_ < REPS(PH_SCAN0); ++rep_) { if (rep_) __syncthreads(); dn_chain_phase(a, lds, vcu, G);
#if defined(SUBP) && SUBP == 2
        dn_chain_phase(a, lds, vcu, G);
#endif
        rg_carry_phase(a, vcu, G); } SEAM(PH_SCAN0);
    if (IN(PH_MERGE0)) for (int rep_ = 0; rep_ < REPS(PH_MERGE0); ++rep_) { if (rep_) __syncthreads(); rg_final_phase(a, vcu, G); merge0_phase(a, vcu, G); } SEAM(PH_MERGE0);
    if (IN(PH_GOUT0)) for (int rep_ = 0; rep_ < REPS(PH_GOUT0); ++rep_) { if (rep_) __syncthreads(); Gemm g{(const bf16_t*)(ws + WS_Y), (const bf16_t*)(ws + WS_WOUT0), 1024}; CtxSplitOrder<16, 4> S{G, vcu};
        EpiResid<0> E{a.in[I_X], a.out, a.in[I_CTX], (float*)(ws + WS_HCTX), (const float*)(ws + WS_MOD) + 2 * 1024, (float*)(ws + WS_PART0)};
        gemm_phase<EpiResid<0>, CtxSplitOrder<16, 4>, true, true>(lds, g, S, E); } SEAM(PH_GOUT0);
    if (IN(PH_NORMF0)) for (int rep_ = 0; rep_ < REPS(PH_NORMF0); ++rep_) { if (rep_) __syncthreads(); norm_phase<1>(a, lds, vcu, G); } SEAM(PH_NORMF0);
    if (IN(PH_GGU0)) for (int rep_ = 0; rep_ < REPS(PH_GGU0); ++rep_) { if (rep_) __syncthreads(); Gemm g{(const bf16_t*)(ws + WS_XN), (const bf16_t*)(ws + WS_WGU0), 1024}; StaticOrder S; S.init(M0, 2 * DFF, G, bx); EpiSwiGLU E{(bf16_t*)(ws + WS_U), DFF};
        gemm_phase<EpiSwiGLU, StaticOrder, true, true>(lds, g, S, E); } SEAM(PH_GGU0);
    if (IN(PH_GDN0)) for (int rep_ = 0; rep_ < REPS(PH_GDN0); ++rep_) { if (rep_) __syncthreads(); Gemm g{(const bf16_t*)(ws + WS_U), (const bf16_t*)(ws + WS_WDN0), DFF}; CtxSplitOrder<44, 8> S{G, vcu};
        EpiResid<0> E{a.out, a.out, (const float*)(ws + WS_HCTX), (float*)(ws + WS_HCTX), (const float*)(ws + WS_MOD) + 5 * 1024, (float*)(ws + WS_PART0)};
        gemm_phase<EpiResid<0>, CtxSplitOrder<44, 8>, true, true>(lds, g, S, E); } SEAM(PH_GDN0);
    if (IN(PH_NORM1)) for (int rep_ = 0; rep_ < REPS(PH_NORM1); ++rep_) { if (rep_) __syncthreads(); norm_phase<2>(a, lds, vcu, G); } SEAM(PH_NORM1);
    if (IN(PH_GIN1)) for (int rep_ = 0; rep_ < REPS(PH_GIN1); ++rep_) { if (rep_) __syncthreads(); Gemm g{(const bf16_t*)(ws + WS_XN), (const bf16_t*)(ws + WS_WIN1), 1024}; StaticOrder S; S.init(M0, NU1S, G, bx); EpiBf16 E{(bf16_t*)(ws + WS_U), NU1S};
        gemm_phase<EpiBf16, StaticOrder, true, true>(lds, g, S, E); } SEAM(PH_GIN1);
    if (IN(PH_PREP1)) for (int rep_ = 0; rep_ < REPS(PH_PREP1); ++rep_) { if (rep_) __syncthreads(); scan1_prep_phase(a, lds, vcu, G); } SEAM(PH_PREP1);
    if (IN(PH_CHAIN1)) for (int rep_ = 0; rep_ < REPS(PH_CHAIN1); ++rep_) { if (rep_) __syncthreads(); scan1_chain_phase(a, lds, vcu, G); } SEAM(PH_CHAIN1);
    if (IN(PH_MERGE1)) for (int rep_ = 0; rep_ < REPS(PH_MERGE1); ++rep_) { if (rep_) __syncthreads(); merge1_phase(a, vcu, G); } SEAM(PH_MERGE1);
    if (IN(PH_GOUT1)) for (int rep_ = 0; rep_ < REPS(PH_GOUT1); ++rep_) { if (rep_) __syncthreads(); Gemm g{(const bf16_t*)(ws + WS_Y), (const bf16_t*)(ws + WS_WOUT1), 1024}; StaticOrder S; S.init(ML, 1024, G, bx);
        EpiResid<1> E{a.out, a.out, nullptr, nullptr, (const float*)(ws + WS_MOD) + 9 * 6144 + 2 * 1024, nullptr};
        gemm_phase<EpiResid<1>, StaticOrder, true, true>(lds, g, S, E); } SEAM(PH_GOUT1);
    if (IN(PH_NORMF1)) for (int rep_ = 0; rep_ < REPS(PH_NORMF1); ++rep_) { if (rep_) __syncthreads(); norm_phase<3>(a, lds, vcu, G); __syncthreads(); moe_weight_copies(a, lds, vcu, G);
#if defined(SUBP) && SUBP == 8
        __syncthreads(); moe_weight_copies(a, lds, vcu, G);
#endif
        } SEAM(PH_NORMF1);
    if (IN(PH_SORT)) for (int rep_ = 0; rep_ < REPS(PH_SORT); ++rep_) { if (rep_) __syncthreads(); moe_sort_phase(a, vcu, G); } SEAM(PH_SORT);
    if (IN(PH_MGU)) for (int rep_ = 0; rep_ < REPS(PH_MGU); ++rep_) { if (rep_) __syncthreads(); const unsigned* ctl = (const unsigned*)(ws + WS_CTL);
        Gemm g{(const bf16_t*)(ws + WS_XS), (const bf16_t*)(ws + WS_WGU1), 1024}; const int ntl = (int)__hip_atomic_load(ctl + CW_NTILES, RLX_AGENT); GroupOrder S{(const int*)(ctl + CW_TILE_E), ntl, 22, G, vcu, 16, ntl * 22, 1}; EpiSwiGLU E{(bf16_t*)(ws + WS_ACTS), DFF};
        gemm_phase<EpiSwiGLU, GroupOrder, true, true>(lds, g, S, E); } SEAM(PH_MGU);
    if (IN(PH_MDN)) for (int rep_ = 0; rep_ < REPS(PH_MDN); ++rep_) { if (rep_) __syncthreads(); const unsigned* ctl = (const unsigned*)(ws + WS_CTL);
        Gemm g{(const bf16_t*)(ws + WS_ACTS), (const bf16_t*)(ws + WS_WDN1), DFF}; const int ntl = (int)__hip_atomic_load(ctl + CW_NTILES, RLX_AGENT), tF = (int)__hip_atomic_load(ctl + CW_TAILF, RLX_AGENT), tS = (int)__hip_atomic_load(ctl + CW_TAILS, RLX_AGENT);
        GroupOrder S{(const int*)(ctl + CW_TILE_E), ntl, 4, G, vcu, 44, tF, tS}; EpiF32 E{(bf16_t*)(ws + WS_OUTS), 1024, ws, (tF / 4) * 256, tS};
        gemm_phase<EpiF32, GroupOrder, true, true>(lds, g, S, E); } SEAM(PH_MDN);
    if (IN(PH_FINAL)) for (int rep_ = 0; rep_ < REPS(PH_FINAL); ++rep_) { if (rep_) __syncthreads(); final_phase(a, vcu, G); }
#undef IN
#undef SEAM
}

extern "C" void kernel_launch(void* const* d_in, const int* in_sizes, int n_in, void* d_out, int out_size, void* d_ws, size_t ws_size, hipStream_t stream) {
    static int grid = 0;
    if (grid == 0) {
        if (n_in != N_IN || out_size != ML * D || ws_size < WS_END) { fprintf(stderr, "kernel_launch: unexpected shapes (n_in %d out %d ws %zu)\n", n_in, out_size, ws_size); grid = -1; return; }
        int dev = 0, cus = 0, per_cu = 0;
        if (hipGetDevice(&dev) != hipSuccess || hipDeviceGetAttribute(&cus, hipDeviceAttributeMultiprocessorCount, dev) != hipSuccess) { grid = -1; return; }
        if (hipFuncSetAttribute((const void*)mk_fwd, hipFuncAttributeMaxDynamicSharedMemorySize, LDS_BYTES) != hipSuccess) { fprintf(stderr, "kernel_launch: hipFuncSetAttribute failed\n"); grid = -1; return; }
        if (hipOccupancyMaxActiveBlocksPerMultiprocessor(&per_cu, (const void*)mk_fwd, NT, LDS_BYTES) != hipSuccess || per_cu < 1) { fprintf(stderr, "kernel_launch: occupancy query says %d\n", per_cu); }
        (void)hipGetLastError();
        grid = cus;
    }
    if (grid < 0) return;
    if (hipMemsetAsync((char*)d_ws + WS_CTL, 0, CTL_ZERO_BYTES, stream) != hipSuccess) return;
    Args a{};
    for (int i = 0; i < N_IN; ++i) a.in[i] = (const float*)d_in[i];
    a.out = (float*)d_out; a.ws = (unsigned char*)d_ws;
#ifndef MK_SINGLE
    for (int p = 0; p < NPHASE; ++p) { a.ph_lo = p; a.ph_hi = p + 1; hipLaunchKernelGGL(mk_fwd, dim3(grid), dim3(NT), LDS_BYTES, stream, a); }
#else
    a.ph_lo = 0; a.ph_hi = NPHASE; hipLaunchKernelGGL(mk_fwd, dim3(grid), dim3(NT), LDS_BYTES, stream, a);
#endif
}
```

```cpp
#define MK_SINGLE 1
#include <hip/hip_runtime.h>
#include <cstdio>
#include <cstdint>

__device__ __forceinline__ int tid_fresh() { int t = threadIdx.x; asm volatile("" : "+v"(t)); return t; }
namespace pg8 {
#define PG8_LAS __attribute__((address_space(3)))
typedef unsigned short bf16_t;
typedef short bf16x8 __attribute__((ext_vector_type(8)));
typedef float f32x4 __attribute__((ext_vector_type(4)));
typedef unsigned u32x4 __attribute__((ext_vector_type(4)));
constexpr int BM = 256, BK = 64, HALF = 128, HTB = HALF * BK * 2  , STAGE_BYTES = 8 * HTB, NXCD = 8, WGM = 8;

__host__ __device__ __forceinline__ int lds_byte(int r, int c) { const int st = (r >> 4) * 2 + (c >> 5), rr = r & 15, cc = c & 31, ob = rr * 64 + cc * 2; return st * 1024 + (ob ^ (((ob >> 9) & 1) << 5)); }
__host__ __device__ __forceinline__ void stage_rc(int b, int& R, int& C) { const int st = b / 1024, sb = b % 1024, swz = sb ^ (((sb >> 9) & 1) << 5); R = (st >> 1) * 16 + swz / 64; C = (st & 1) * 32 + (swz % 64) / 2; }
__host__ __device__ __forceinline__ int perm32(int rho) { const int n = rho >> 4, i = rho & 15; return 8 * (i >> 2) + 4 * n + (i & 3); }

struct Unit { int pm, pn, pb, ko, nkt, split; };
struct Gemm { const bf16_t* A; const bf16_t* Bt; int K; };

__host__ __device__ __forceinline__ int tail_slices(int R, int G, int kt) { if (R <= 0 || kt != 44) return 1; const int q = G / R; return q >= 8 ? 8 : (q >= 4 ? 4 : (q >= 2 ? 2 : 1)); }
__host__ __device__ __forceinline__ void tail_slice(int S, int s, int kt, int& ko, int& nkt) {
    if (S == 8) { nkt = s < 6 ? 6 : 4; ko = 64 * (s < 6 ? 6 * s : 36 + 4 * (s - 6)); }
    else if (S == 4 && kt == 16) { nkt = 4; ko = 256 * s; }
    else if (S == 4) { nkt = s < 2 ? 12 : 10; ko = 64 * (s < 2 ? 12 * s : 24 + 10 * (s - 2)); }
    else if (S == 2) { nkt = 22; ko = 64 * 22 * s; }
    else { nkt = kt; ko = 0; }
}
struct StaticOrder {
    int nM, nN, nwg, G, c, kt, F, S;
    __host__ __device__ __forceinline__ void init(int M, int N, int G_, int c_, int K = 1024, bool split_tail = false) { nM = M / BM; nN = N / BM; nwg = nM * nN; G = G_; c = c_; kt = K / BK;
        F = (nwg / G) * G; S = split_tail ? tail_slices(nwg - F, G, kt) : 1; if (S == 1) F = nwg; }
    __host__ __device__ __forceinline__ bool next(int i, Unit& u) const {
        long L = (long)i * G + c; u.ko = 0; u.nkt = kt; u.split = 0;
        if (L >= F) { const long t = L - F; if (t >= (long)(nwg - F) * S) return false; const int s = (int)(t % S); L = F + t / S; tail_slice(S, s, kt, u.ko, u.nkt); u.split = 1; }
        int wgid = (int)L; { const int q = nwg / NXCD, r = nwg % NXCD, xcd = wgid % NXCD, off = wgid / NXCD; wgid = (xcd < r ? xcd * (q + 1) : r * (q + 1) + (xcd - r) * q) + off; }
        const int nig = WGM * nN, gid = wgid / nig, fm = gid * WGM, gsz = (nM - fm) < WGM ? (nM - fm) : WGM;
        u.pm = fm + ((wgid % nig) % gsz); u.pn = (wgid % nig) / gsz; u.pb = u.pn; return true;
    }
    __device__ __forceinline__ void a_ready(const Unit&) const {}
    __device__ __forceinline__ void done(const Unit&) const {}
};
template <int KT, int S> struct CtxSplitOrder {
    int G, c;
    __device__ __forceinline__ bool next(int i, Unit& u) const {
        const int L = i * G + c; u.ko = 0; u.nkt = KT; u.split = 0;
        if (L < 256) { u.pm = L >> 2; u.pn = L & 3; u.pb = u.pn; return true; }
        const int t = L - 256; if (t >= 32 * S) return false;
        const int cu = t / S, s = t - cu * S; u.pm = 64 + (cu >> 2); u.pn = cu & 3; u.pb = u.pn; tail_slice(S, s, KT, u.ko, u.nkt); u.split = s + 1; return true;
    }
    __device__ __forceinline__ void a_ready(const Unit&) const {}
    __device__ __forceinline__ void done(const Unit&) const {}
};
struct GroupOrder {
    const int* tile_e; int ntiles, npn, G, c, kt, F, S;
    __device__ __forceinline__ bool next(int i, Unit& u) const {
        int L = i * G + c; u.ko = 0; u.nkt = kt; u.split = 0;
        if (L >= F) { const int t = L - F; if (t >= (ntiles * npn - F) * S) return false; const int s = t % S; L = F + t / S; if (S > 1) { tail_slice(S, s, kt, u.ko, u.nkt); u.split = s + 1; } }
        if (npn == 22) {
            const int sr = L / 176, r = L - sr * 176, rem = ntiles - 8 * sr, tq = rem < 8 ? rem : 8, r2 = rem < 8 ? L - sr * 176 : r;
            const int blk = r2 / (4 * tq), w = r2 - blk * 4 * tq; u.pm = sr * 8 + w % tq; u.pn = blk * 4 + w / tq;
        } else { u.pm = L / npn; u.pn = L - u.pm * npn; } u.pb = __hip_atomic_load(tile_e + u.pm, __ATOMIC_RELAXED, __HIP_MEMORY_SCOPE_AGENT) * npn + u.pn; return true;
    }
    __device__ __forceinline__ void a_ready(const Unit&) const {}
    __device__ __forceinline__ void done(const Unit&) const {}
};

__host__ __device__ __forceinline__ float* moe_part_base(unsigned char* wsb, int s, int S) {
    const size_t MiB_ = 1u << 20, sz = (S == 8 ? 8 : 16) * MiB_; const int nhi = S == 8 ? 6 : 3;
    return (float*)(wsb + (s < nhi ? 389 * MiB_ + (size_t)s * sz : 182 * MiB_ + (size_t)(s - nhi) * sz));
}
typedef float f32x2_e __attribute__((ext_vector_type(2)));
typedef __bf16 bf16x2_e __attribute__((ext_vector_type(2)));
__device__ __forceinline__ unsigned cvt_pk_bf16(float lo, float hi) { const f32x2_e v = {lo, hi}; return __builtin_bit_cast(unsigned, __builtin_convertvector(v, bf16x2_e)); }

struct EpiBf16 {
    static constexpr bool PERM = true, AFTER_DRAIN = false;
    bf16_t* O; int ldc;
    __device__ __forceinline__ void operator()(const f32x4 (&acc)[2][2][4][2], const Unit& u, int wr, int wc, int fr, int fq) const {
        const int row0 = u.pm * BM + wr * 64 + fr, col0 = u.pn * BM + wc * 32 + 8 * fq;
#pragma unroll
        for (int ai = 0; ai < 2; ++ai)
#pragma unroll
            for (int m = 0; m < 4; ++m) { bf16_t* rowp = O + (size_t)(row0 + ai * HALF + m * 16) * ldc + col0;
#pragma unroll
                for (int bj = 0; bj < 2; ++bj) { const f32x4 v0 = acc[ai][bj][m][0], v1 = acc[ai][bj][m][1];
                    u32x4 w; w.x = cvt_pk_bf16(v0[0], v0[1]); w.y = cvt_pk_bf16(v0[2], v0[3]); w.z = cvt_pk_bf16(v1[0], v1[1]); w.w = cvt_pk_bf16(v1[2], v1[3]);
                    *(u32x4*)(rowp + bj * HALF) = w; } }
    }
};
struct EpiSwiGLU {
    static constexpr bool PERM = true, AFTER_DRAIN = false;
    bf16_t* O; int ldc;
    __device__ __forceinline__ void operator()(const f32x4 (&acc)[2][2][4][2], const Unit& u, int wr, int wc, int fr, int fq) const {
        const int row0 = u.pm * BM + wr * 64 + fr, col0 = u.pn * HALF + wc * 32 + 8 * fq;
#pragma unroll
        for (int ai = 0; ai < 2; ++ai)
#pragma unroll
            for (int m = 0; m < 4; ++m) { bf16_t* rowp = O + (size_t)(row0 + ai * HALF + m * 16) * ldc + col0;
                float r[8];
#pragma unroll
                for (int n = 0; n < 2; ++n)
#pragma unroll
                    for (int j = 0; j < 4; ++j) { const float g = acc[ai][0][m][n][j], up = acc[ai][1][m][n][j]; r[n * 4 + j] = g * up * __builtin_amdgcn_rcpf(1.0f + __expf(-g)); }
                u32x4 w; w.x = cvt_pk_bf16(r[0], r[1]); w.y = cvt_pk_bf16(r[2], r[3]); w.z = cvt_pk_bf16(r[4], r[5]); w.w = cvt_pk_bf16(r[6], r[7]);
                *(u32x4*)rowp = w; }
    }
};
template <int MODE> struct EpiResid {
    static constexpr bool PERM = false, AFTER_DRAIN = false;
    const float* base_lat; float* out_lat; const float* base_ctx; float* out_ctx; const float* gate;
    float* part;
    __device__ __forceinline__ void operator()(const f32x4 (&acc)[2][2][4][2], const Unit& u, int wr, int wc, int fr, int fq) const {
        const int row0 = u.pm * BM + wr * 64 + fr, col0 = u.pn * BM + wc * 32 + 4 * fq;
        const int sg = MODE == 0 ? (u.pm < 64 ? (u.pm >> 3) : 8) : (u.pm >> 3);
        f32x4 g[2][2];
#pragma unroll
        for (int bj = 0; bj < 2; ++bj)
#pragma unroll
            for (int n = 0; n < 2; ++n) g[bj][n] = *(const f32x4*)(gate + sg * 6144 + col0 + bj * HALF + n * 16);
#pragma unroll
        for (int ai = 0; ai < 2; ++ai) {
            const float* bp[4]; float* op[4];
#pragma unroll
            for (int m = 0; m < 4; ++m) { const int r = row0 + ai * HALF + m * 16;
                if (MODE == 0) { if (r < 16384) { bp[m] = base_lat + (size_t)r * 1024; op[m] = out_lat + (size_t)r * 1024; } else { bp[m] = base_ctx + (size_t)(r - 16384) * 1024; op[m] = out_ctx + (size_t)(r - 16384) * 1024; } }
                else { const int p = r & 2047, tok = (r & ~2047) + (p & 31) * 64 + (p >> 5); bp[m] = base_lat + (size_t)tok * 1024; op[m] = out_lat + (size_t)tok * 1024; } }
            if (MODE == 0 && u.split) {
#pragma unroll
                for (int m = 0; m < 4; ++m) { const int r = row0 + ai * HALF + m * 16;
#pragma unroll
                    for (int bj = 0; bj < 2; ++bj)
#pragma unroll
                        for (int n = 0; n < 2; ++n) *(f32x4*)(part + ((size_t)(u.split - 1) * 2048 + (r - 16384)) * 1024 + col0 + bj * HALF + n * 16) = g[bj][n] * acc[ai][bj][m][n]; }
            } else {
                f32x4 b[4][2][2];
#pragma unroll
                for (int m = 0; m < 4; ++m)
#pragma unroll
                    for (int bj = 0; bj < 2; ++bj)
#pragma unroll
                        for (int n = 0; n < 2; ++n) b[m][bj][n] = *(const f32x4*)(bp[m] + col0 + bj * HALF + n * 16);
#pragma unroll
                for (int m = 0; m < 4; ++m)
#pragma unroll
                    for (int bj = 0; bj < 2; ++bj)
#pragma unroll
                        for (int n = 0; n < 2; ++n) *(f32x4*)(op[m] + col0 + bj * HALF + n * 16) = b[m][bj][n] + g[bj][n] * acc[ai][bj][m][n];
            }
        }
    }
};
struct EpiF32 {
    static constexpr bool PERM = false, AFTER_DRAIN = false;
    bf16_t* C; int ldc; unsigned char* wsb; int tail_row0, S;
    __device__ __forceinline__ void operator()(const f32x4 (&acc)[2][2][4][2], const Unit& u, int wr, int wc, int fr, int fq) const {
        const int row0 = u.pm * BM + wr * 64 + fr, col0 = u.pn * BM + wc * 32 + 4 * fq;
#pragma unroll
        for (int ai = 0; ai < 2; ++ai)
#pragma unroll
            for (int m = 0; m < 4; ++m) { const int r = row0 + ai * HALF + m * 16;
                if (u.split) { float* rowp = moe_part_base(wsb, u.split - 1, S) + (size_t)(r - tail_row0) * ldc + col0;
#pragma unroll
                    for (int bj = 0; bj < 2; ++bj)
#pragma unroll
                        for (int n = 0; n < 2; ++n) *(f32x4*)(rowp + bj * HALF + n * 16) = acc[ai][bj][m][n]; }
                else { bf16_t* rowp = C + (size_t)r * ldc + col0;
#pragma unroll
                    for (int bj = 0; bj < 2; ++bj)
#pragma unroll
                        for (int n = 0; n < 2; ++n) { const f32x4 v = acc[ai][bj][m][n]; typedef unsigned u32x2_ __attribute__((ext_vector_type(2))); u32x2_ w; w.x = cvt_pk_bf16(v[0], v[1]); w.y = cvt_pk_bf16(v[2], v[3]); *(u32x2_*)(rowp + bj * HALF + n * 16) = w; } } }
    }
};


template <class Epi, class Sched, bool ALIGN_EPI = false, bool SP2 = false>
__device__ __forceinline__ void gemm_phase(PG8_LAS unsigned char* lds, const Gemm g, const Sched& S, const Epi& E) {
    const int tid = tid_fresh(), wid = __builtin_amdgcn_readfirstlane(tid >> 6), lane = tid & 63, wr = wid >> 2, wc = wid & 3, fr = lane & 15, fq = lane >> 4;
    const int K = g.K;
    unsigned voffA[2], voffB[2];
#pragma unroll
    for (int i = 0; i < 2; ++i) { int R, C; stage_rc(tid * 16 + i * 8192, R, C); const int Rb = Epi::PERM ? ((R & ~31) + perm32(R & 31)) : R;
        voffA[i] = (unsigned)(R * K + C) * 2u; voffB[i] = (unsigned)(Rb * K + C) * 2u; }
    const size_t kstep = (size_t)(BK * 2);
    const size_t hstep = (size_t)HALF * K * 2;
    const size_t tstep = 2 * hstep;
    const unsigned ldsw = (unsigned)wid * 1024u;
    const int aoff = lds_byte(wr * 64 + fr, fq * 8), boff = lds_byte(wc * 32 + fr, fq * 8);
#define PG8_SA(b, h) (((b) * 2 + (h)) * HTB)
#define PG8_SB(b, h) ((4 + (b) * 2 + (h)) * HTB)
#define PG8_STAGE(bufoff, gbase, voff) do { _Pragma("unroll") for (int _i = 0; _i < 2; ++_i) \
        __builtin_amdgcn_global_load_lds((const unsigned*)((const char*)(gbase) + (voff)[_i]), (PG8_LAS unsigned*)(lds + (bufoff) + ldsw + _i * 8192), 16, 0, 0); } while (0)
#define PG8_LDA(dst, b, h) do { _Pragma("unroll") for (int m = 0; m < 4; ++m) _Pragma("unroll") for (int k = 0; k < 2; ++k) dst[m][k] = *(const PG8_LAS bf16x8*)(lds + PG8_SA(b, h) + aoff + m * 2048 + k * 1024); } while (0)
#define PG8_LDB(dst, b, h) do { _Pragma("unroll") for (int n = 0; n < 2; ++n) _Pragma("unroll") for (int k = 0; k < 2; ++k) dst[n][k] = *(const PG8_LAS bf16x8*)(lds + PG8_SB(b, h) + boff + n * 2048 + k * 1024); } while (0)
#define PG8_MMA(ai, bj, At, Bt) do { __builtin_amdgcn_s_setprio(1); _Pragma("unroll") for (int m = 0; m < 4; ++m) _Pragma("unroll") for (int n = 0; n < 2; ++n) _Pragma("unroll") for (int k = 0; k < 2; ++k) \
        acc[ai][bj][m][n] = __builtin_amdgcn_mfma_f32_16x16x32_bf16(Bt[n][k], At[m][k], acc[ai][bj][m][n], 0, 0, 0); __builtin_amdgcn_s_setprio(0); } while (0)
#define PG8_WAIT_V(n) asm volatile("s_waitcnt vmcnt(" #n ")" ::: "memory")
#define PG8_WAIT_L(n) asm volatile("s_waitcnt lgkmcnt(" #n ")" ::: "memory")
#define PG8_BAR __builtin_amdgcn_s_barrier()
#define PG8_SCHED __builtin_amdgcn_sched_barrier(0)
    Unit cur, nxt; int ui = 0;
    if (!S.next(0, cur)) return;
    f32x4 acc[2][2][4][2];
#pragma unroll
    for (int a = 0; a < 2; ++a)
#pragma unroll
        for (int b = 0; b < 2; ++b)
#pragma unroll
            for (int m = 0; m < 4; ++m)
#pragma unroll
                for (int n = 0; n < 2; ++n) acc[a][b][m][n] = (f32x4){0.f, 0.f, 0.f, 0.f};
    bf16x8 At[4][2], B0[2][2], B1[2][2];
    const char* cA = (const char*)g.A + (size_t)cur.pm * tstep + (size_t)cur.ko * 2; const char* cB = (const char*)g.Bt + (size_t)cur.pb * tstep + (size_t)cur.ko * 2; int nt = cur.nkt;
    S.a_ready(cur);
    if constexpr (SP2) {
        PG8_STAGE(PG8_SB(0, 0), cB, voffB); PG8_STAGE(PG8_SB(0, 1), cB + hstep, voffB); PG8_STAGE(PG8_SA(0, 0), cA, voffA); PG8_STAGE(PG8_SA(0, 1), cA + hstep, voffA);
        if (wr == 1) PG8_BAR;
        PG8_WAIT_V(2); PG8_BAR;
        PG8_STAGE(PG8_SB(1, 0), cB + kstep, voffB); PG8_STAGE(PG8_SA(1, 0), cA + kstep, voffA); PG8_STAGE(PG8_SB(1, 1), cB + hstep + kstep, voffB);
        PG8_WAIT_V(6); PG8_BAR;
    } else {
        PG8_STAGE(PG8_SB(0, 0), cB, voffB); PG8_STAGE(PG8_SA(0, 0), cA, voffA); PG8_STAGE(PG8_SB(0, 1), cB + hstep, voffB); PG8_STAGE(PG8_SA(0, 1), cA + hstep, voffA);
        if (wr == 1) PG8_BAR;
        PG8_WAIT_V(4); PG8_BAR;
        PG8_STAGE(PG8_SB(1, 0), cB + kstep, voffB); PG8_STAGE(PG8_SA(1, 0), cA + kstep, voffA); PG8_STAGE(PG8_SB(1, 1), cB + hstep + kstep, voffB);
        PG8_WAIT_V(6); PG8_BAR;
    }
    for (;;) {
        const bool has_next = S.next(ui + 1, nxt);
        const char* nA = has_next ? (const char*)g.A + (size_t)nxt.pm * tstep + (size_t)nxt.ko * 2 : cA; const char* nB = has_next ? (const char*)g.Bt + (size_t)nxt.pb * tstep + (size_t)nxt.ko * 2 : cB;
        for (int t = 0; t < nt; t += 2) {
            const bool last = (t == nt - 2);
            const char* a1 = cA + (size_t)(t + 1) * kstep;
            const char* a2 = last ? nA : cA + (size_t)(t + 2) * kstep; const char* b2 = last ? nB : cB + (size_t)(t + 2) * kstep;
            const char* a3 = a2 + kstep; const char* b3 = b2 + kstep;
            if (last && has_next) S.a_ready(nxt);
            if constexpr (SP2) {
            PG8_LDB(B0, 0, 0); PG8_LDB(B1, 0, 1); PG8_SCHED; PG8_LDA(At, 0, 0); PG8_STAGE(PG8_SA(1, 1), a1 + hstep, voffA);
            PG8_WAIT_V(8); PG8_WAIT_L(0); PG8_BAR; PG8_MMA(0, 0, At, B0); PG8_MMA(0, 1, At, B1); PG8_BAR; PG8_SCHED;
            PG8_LDA(At, 0, 1); PG8_STAGE(PG8_SB(0, 0), b2, voffB); PG8_STAGE(PG8_SB(0, 1), b2 + hstep, voffB); PG8_STAGE(PG8_SA(0, 0), a2, voffA);
            PG8_WAIT_V(8); PG8_WAIT_L(0); PG8_BAR; PG8_MMA(1, 0, At, B0); PG8_MMA(1, 1, At, B1); PG8_BAR; PG8_SCHED;
            PG8_LDB(B0, 1, 0); PG8_LDB(B1, 1, 1); PG8_SCHED; PG8_LDA(At, 1, 0); PG8_STAGE(PG8_SA(0, 1), a2 + hstep, voffA);
            PG8_WAIT_V(8); PG8_WAIT_L(0); PG8_BAR; PG8_MMA(0, 0, At, B0); PG8_MMA(0, 1, At, B1); PG8_BAR; PG8_SCHED;
            PG8_LDA(At, 1, 1); PG8_STAGE(PG8_SB(1, 0), b3, voffB); PG8_STAGE(PG8_SB(1, 1), b3 + hstep, voffB); PG8_STAGE(PG8_SA(1, 0), a3, voffA);
            PG8_WAIT_V(8); PG8_WAIT_L(0); PG8_BAR; PG8_MMA(1, 0, At, B0); PG8_MMA(1, 1, At, B1); PG8_BAR; PG8_SCHED;
            } else {
            PG8_LDB(B0, 0, 0); PG8_SCHED; PG8_LDA(At, 0, 0); PG8_STAGE(PG8_SA(1, 1), a1 + hstep, voffA);
            PG8_WAIT_L(8); PG8_BAR; PG8_WAIT_L(0); PG8_MMA(0, 0, At, B0); PG8_BAR; PG8_SCHED;
            PG8_LDB(B1, 0, 1); PG8_STAGE(PG8_SB(0, 0), b2, voffB);
            PG8_BAR; PG8_WAIT_L(0); PG8_MMA(0, 1, At, B1); PG8_BAR;
            PG8_LDA(At, 0, 1); PG8_STAGE(PG8_SA(0, 0), a2, voffA);
            PG8_BAR; PG8_WAIT_L(0); PG8_MMA(1, 0, At, B0); PG8_BAR; PG8_SCHED;
            PG8_STAGE(PG8_SB(0, 1), b2 + hstep, voffB);
            PG8_WAIT_V(6); PG8_BAR; PG8_MMA(1, 1, At, B1); PG8_BAR;
            PG8_LDB(B0, 1, 0); PG8_SCHED; PG8_LDA(At, 1, 0); PG8_STAGE(PG8_SA(0, 1), a2 + hstep, voffA);
            PG8_WAIT_L(8); PG8_BAR; PG8_WAIT_L(0); PG8_MMA(0, 0, At, B0); PG8_BAR; PG8_SCHED;
            PG8_LDB(B1, 1, 1); PG8_STAGE(PG8_SB(1, 0), b3, voffB);
            PG8_BAR; PG8_WAIT_L(0); PG8_MMA(0, 1, At, B1); PG8_BAR;
            PG8_LDA(At, 1, 1); PG8_STAGE(PG8_SA(1, 0), a3, voffA);
            PG8_BAR; PG8_WAIT_L(0); PG8_MMA(1, 0, At, B0); PG8_BAR; PG8_SCHED;
            PG8_STAGE(PG8_SB(1, 1), b3 + hstep, voffB);
            PG8_WAIT_V(6); PG8_BAR; PG8_MMA(1, 1, At, B1); PG8_BAR;
            }
        }
        if constexpr (ALIGN_EPI) { if (wr == 0) PG8_BAR; }
        if constexpr (!Epi::AFTER_DRAIN) { E(acc, cur, wr, wc, fr, fq); S.done(cur); }
        if (!has_next) break;
#pragma unroll
        for (int a = 0; a < 2; ++a)
#pragma unroll
            for (int b = 0; b < 2; ++b)
#pragma unroll
                for (int m = 0; m < 4; ++m)
#pragma unroll
                    for (int n = 0; n < 2; ++n) acc[a][b][m][n] = (f32x4){0.f, 0.f, 0.f, 0.f};
        cur = nxt; cA = nA; cB = nB; nt = cur.nkt; ++ui;
        if constexpr (ALIGN_EPI) { if (wr == 1) PG8_BAR; }
    }
    PG8_WAIT_V(0);
    if constexpr (!ALIGN_EPI) { if (wr == 0) PG8_BAR; }
    PG8_BAR;
    if constexpr (Epi::AFTER_DRAIN) { E.fused(acc, cur, wr, wc, fr, fq, lds, wid, lane); S.done(cur); }
#undef PG8_SA
#undef PG8_SB
#undef PG8_STAGE
#undef PG8_LDA
#undef PG8_LDB
#undef PG8_MMA
#undef PG8_WAIT_V
#undef PG8_WAIT_L
#undef PG8_BAR
#undef PG8_SCHED
}
}

constexpr int NWAVES = 8, NT = 512;
constexpr int D = 1024, NB = 8, SEQ = 2048, CTXL = 256, ML = NB * SEQ, MC = NB * CTXL, M0 = ML + MC;
constexpr int E_IN = 3088, O_IN = 4128, DFF = 2816, NEXP = 8, NU0 = 3072, NU1 = 4096;
constexpr int NU0S = 3328, NU1S = 4352;
constexpr float EPS = 1e-6f;
constexpr int MPAD = 2 * ML + NEXP * 256;

enum { I_X = 0, I_C, I_CTX, I_CCTX, I_ADAW, I_ADAB, I_NMIX, I_NFFN, I_FINALG, I_EWIN, I_EWOUT, I_ACONVW, I_ACONVB, I_AGATEW, I_AGATEB, I_ALAM,
       I_BCONVW, I_BALOG, I_BDT, I_BNORMG, I_EFG, I_EFU, I_EFD, I_OWIN, I_OWOUT, I_LBLOG, I_CNORMG, I_DGW2, I_DGB2, I_DNORMG, I_RW, I_RB, I_MG, I_MU, I_MD, N_IN };

constexpr size_t MiB = 1u << 20;
constexpr size_t WS_CTL = 0, CTL_ZERO_BYTES = 1 * MiB;
constexpr size_t WS_MOD = 1 * MiB;
constexpr size_t WS_TOPK = 1 * MiB + 512 * 1024;
constexpr size_t WS_WIN0 = 2 * MiB, WS_WOUT0 = 9 * MiB, WS_WGU0 = 11 * MiB, WS_WDN0 = 22 * MiB, WS_WIN1 = 28 * MiB, WS_WOUT1 = 37 * MiB;
constexpr size_t WS_GS = 37 * MiB;
constexpr size_t WS_HCTX = 40 * MiB;
constexpr size_t WS_XN = 48 * MiB;
constexpr size_t WS_Y = 84 * MiB;
constexpr size_t WS_U = 120 * MiB;
constexpr size_t WS_DNQ = 273 * MiB, WS_DNK = 291 * MiB, WS_DNV = 309 * MiB;
constexpr size_t WS_DNO = 327 * MiB;
constexpr size_t WS_RGH = 354 * MiB;
constexpr size_t WS_O1 = 273 * MiB;
constexpr size_t WS_WDN1 = 2 * MiB, WS_WGU1 = 46 * MiB, WS_XS = 134 * MiB, WS_ACTS = 202 * MiB, WS_XN2 = 389 * MiB, WS_OUTS = 46 * MiB;
constexpr size_t WS_QDH = 337 * MiB, WS_QDG = 369 * MiB, WS_KTH = 385 * MiB, WS_KTG = 421 * MiB, WS_A1 = 48 * MiB, WS_DT1 = 40 * MiB;
constexpr size_t WS_DNT = 48 * MiB, WS_DNA = 66 * MiB, WS_DNVEC = 40 * MiB;
constexpr size_t WS_GWT = 39 * MiB + 512 * 1024, WS_RGSUM = 43 * MiB;
constexpr size_t WS_RGCARRY = 435 * MiB, WS_RGAX = 363 * MiB;
constexpr size_t WS_PART0 = 273 * MiB;
constexpr size_t WS_END = 440 * MiB;
constexpr int CW_TMO = 0, CW_CNT = 64  , CW_NTILES = 640, CW_TAILF = 641, CW_TAILS = 642, CW_TILE_E = 704, CW_BAR = 4096;

#define GAS __attribute__((address_space(1)))
#define LAS __attribute__((address_space(3)))
#define DI __device__ __forceinline__
typedef unsigned short bf16;
typedef unsigned v4u __attribute__((ext_vector_type(4)));
typedef unsigned v2u __attribute__((ext_vector_type(2)));
typedef float f32x4 __attribute__((ext_vector_type(4)));
typedef short bf16x8 __attribute__((ext_vector_type(8)));
typedef GAS unsigned gu32;
#define RLX_AGENT __ATOMIC_RELAXED, __HIP_MEMORY_SCOPE_AGENT
#define LDS_WAIT() asm volatile("s_waitcnt lgkmcnt(0)" ::: "memory")
#define LDS_BARRIER() do { asm volatile("s_waitcnt lgkmcnt(0)" ::: "memory"); __builtin_amdgcn_s_barrier(); asm volatile("" ::: "memory"); } while (0)
typedef float f32x2_t __attribute__((ext_vector_type(2)));
typedef __bf16 bf16x2_t __attribute__((ext_vector_type(2)));
DI unsigned pk2(float lo, float hi) { const f32x2_t v = {lo, hi}; return __builtin_bit_cast(unsigned, __builtin_convertvector(v, bf16x2_t)); }
DI unsigned f2bf(float f) { return pk2(f, 0.0f) & 0xffffu; }
DI float bflo(unsigned u) { return __builtin_bit_cast(float, u << 16); }
DI float bfhi(unsigned u) { return __builtin_bit_cast(float, u & 0xffff0000u); }
DI float bf2f(bf16 b) { return __builtin_bit_cast(float, (unsigned)b << 16); }
DI float frcp(float x) { return __builtin_amdgcn_rcpf(x); }
DI float sigm(float x) { return frcp(1.0f + __expf(-x)); }
DI float silu_(float x) { return x * sigm(x); }
DI float softplus_(float x) { return fmaxf(x, 0.f) + log1pf(expf(-fabsf(x))); }
DI float softplus_fast(float x) { return fmaxf(x, 0.f) + __logf(1.0f + __expf(-fabsf(x))); }
DI float gelu_tanh(float x) { return x * sigm(1.5957691216057308f * (x + 0.044715f * x * x * x)); }
template <int CTRL> DI float dpp_mov(float v) { return __builtin_bit_cast(float, __builtin_amdgcn_update_dpp(0, __builtin_bit_cast(int, v), CTRL, 0xF, 0xF, false)); }
DI float sum4(float v) { v += dpp_mov<0xB1>(v); v += dpp_mov<0x4E>(v); return v; }
DI float sum8(float v) { v = sum4(v); v += dpp_mov<0x141>(v); return v; }
DI float sum16(float v) { v = sum8(v); v += dpp_mov<0x140>(v); return v; }
DI float wave_sum(float v) {
    v = sum16(v);
    const int iv = __builtin_bit_cast(int, v);
    return (__builtin_bit_cast(float, __builtin_amdgcn_readlane(iv, 0)) + __builtin_bit_cast(float, __builtin_amdgcn_readlane(iv, 16))) + (__builtin_bit_cast(float, __builtin_amdgcn_readlane(iv, 32)) + __builtin_bit_cast(float, __builtin_amdgcn_readlane(iv, 48)));
}
DI int rowmap(int b, int d, int p) { return p < CTXL ? ML + b * CTXL + (d ? CTXL - 1 - p : p) : b * SEQ + (d ? SEQ - 1 - (p - CTXL) : (p - CTXL)); }

#define XB_TMO      128
#define XB_XCNT(j)  (256  + 64 * (j))
#define XB_XSUB(j)  (1280 + 64 * (j))
#define XB_XGEN(j)  (2304 + 64 * (j))
#define XB_TOP      3328
#define XB_TOPGEN   3392
#define XCD_BAR_WORDS 3456
#define XB_SPIN_CAP (1u << 18)

__device__ __forceinline__ unsigned xb_ld(unsigned* p)              { return __hip_atomic_load(p, __ATOMIC_RELAXED, __HIP_MEMORY_SCOPE_AGENT); }
__device__ __forceinline__ unsigned xb_add(unsigned* p, unsigned v) { return __hip_atomic_fetch_add(p, v, __ATOMIC_RELAXED, __HIP_MEMORY_SCOPE_AGENT); }
__device__ __forceinline__ unsigned xb_xcc_id() { return (unsigned)__builtin_amdgcn_s_getreg((3 << 11) | 20) & 0xFu; }
#define XB_SPIN(cond, bar) do { unsigned _sp = 0; while (cond) { __builtin_amdgcn_s_sleep(1); \
    if ((++_sp & 255u) == 0u) { if (xb_ld(&(bar)[XB_TMO])) break; if (_sp > XB_SPIN_CAP) { atomicAdd(&(bar)[XB_TMO], 1u); break; } } } } while (0)

struct XcdBarrier {
    unsigned* bar; unsigned x;
    volatile LAS unsigned* st;
};

__device__ __forceinline__ XcdBarrier xcd_barrier_post(unsigned* bar, volatile LAS unsigned* st) {
    XcdBarrier b; b.bar = bar; b.x = xb_xcc_id(); b.st = st;
    if (threadIdx.x == 0) (void)xb_add(&bar[XB_XCNT(b.x)], 1u);
    return b;
}
__device__ __forceinline__ void xcd_barrier_complete(unsigned* bar, unsigned x, unsigned& nloc, unsigned& nx) {
    const unsigned G = gridDim.x * gridDim.y * gridDim.z;
    unsigned sum, cnt, mine, sp = 0u;
    for (;;) {
        sum = 0u; cnt = 0u; mine = 0u;
#pragma unroll
        for (unsigned j = 0; j < 16; ++j) { const unsigned c = xb_ld(&bar[XB_XCNT(j)]); sum += c; cnt += (c > 0u) ? 1u : 0u; mine = (j == x) ? c : mine; }
        if (sum == G) break;
        __builtin_amdgcn_s_sleep(1);
        if ((++sp & 255u) == 0u) { if (xb_ld(&bar[XB_TMO])) break; if (sp > XB_SPIN_CAP) { atomicAdd(&bar[XB_TMO], 1u); break; } }
    }
    nloc = mine > 0u ? mine : 1u; nx = cnt > 0u ? cnt : 1u;
}

__device__ __forceinline__ void xcd_barrier(const XcdBarrier& b) {
    asm volatile("s_waitcnt vmcnt(0)" ::: "memory");
    __syncthreads();
    if (threadIdx.x == 0) {
        unsigned* bar = b.bar;
        __builtin_amdgcn_s_waitcnt(0);
        unsigned nloc = b.st[0], nx = b.st[1];
        if (nloc == 0u) { xcd_barrier_complete(bar, b.x, nloc, nx); b.st[0] = nloc; b.st[1] = nx; }
        const unsigned old = xb_add(&bar[XB_XSUB(b.x)], 1u);
        const unsigned gen = old / nloc;
        if (old + 1u == (gen + 1u) * nloc) {
            __builtin_amdgcn_fence(__ATOMIC_RELEASE, "agent");
            asm volatile("s_waitcnt vmcnt(0)" ::: "memory");
            const unsigned og = xb_add(&bar[XB_TOP], 1u);
            const unsigned tg = og / nx;
            if (og + 1u == (tg + 1u) * nx) xb_add(&bar[XB_TOPGEN], 1u);
            else XB_SPIN(xb_ld(&bar[XB_TOPGEN]) == tg, bar);
            __builtin_amdgcn_fence(__ATOMIC_ACQUIRE, "agent");
            xb_add(&bar[XB_XGEN(b.x)], 1u);
            asm volatile("s_waitcnt vmcnt(0)" ::: "memory");
        } else {
            XB_SPIN(xb_ld(&bar[XB_XGEN(b.x)]) == gen, bar);
            __builtin_amdgcn_fence(__ATOMIC_ACQUIRE, "agent");
            asm volatile("s_waitcnt vmcnt(0)" ::: "memory");
        }
    }
    __syncthreads();
}


struct Args { const float* in[N_IN]; float* out; unsigned char* ws; int ph_lo, ph_hi; };

DI void transpose_item(const float* W, int ldw, int K, bf16* WT, int n_src0, int dst_row0, int k0, LAS float* scr, int lane) {
#pragma unroll 8
    for (int i = 0; i < 32; ++i) { const int kk = 2 * i + (lane >> 5); scr[kk * 33 + (lane & 31)] = W[(size_t)(k0 + kk) * ldw + n_src0 + (lane & 31)]; }
    LDS_WAIT(); asm volatile("" ::: "memory");
    const int c = lane & 7;
#pragma unroll
    for (int j = 0; j < 4; ++j) { const int n = (lane >> 3) + 8 * j; const LAS float* s = scr + (8 * c) * 33 + n;
        v4u o; o.x = pk2(s[0 * 33], s[1 * 33]); o.y = pk2(s[2 * 33], s[3 * 33]); o.z = pk2(s[4 * 33], s[5 * 33]); o.w = pk2(s[6 * 33], s[7 * 33]);
        *(GAS v4u*)(WT + (size_t)(dst_row0 + n) * K + k0 + 8 * c) = o; }
    LDS_WAIT(); asm volatile("" ::: "memory");
}
DI void conv_mat_item(const float* W, int ldw, int K, int ncols, bf16* WT, int mode, int item, LAS float* scr, int lane) {
    const int nblk = ncols / 32, kb = item / nblk, nb = item - kb * nblk, n0 = 32 * nb;
    const int dr = mode == 0 ? n0 : (n0 / 128) * 256 + (mode == 2 ? 128 : 0) + (n0 % 128);
    transpose_item(W, ldw, K, WT, n0, dr, 64 * kb, scr, lane);
}
DI void p0_prologue(const Args& a, LAS unsigned char* lds, int vcu, int G) {
    const int tid = tid_fresh(), lane = tid & 63, wave = __builtin_amdgcn_readfirstlane(tid >> 6);
    unsigned char* ws = a.ws;
    {
        LAS float* sl = (LAS float*)lds;
        LAS float* red = (LAS float*)(lds + 9 * 1024 * 4);
        for (int i = tid; i < 9 * 1024; i += NT) { const int s = i >> 10, k = i & 1023; const float cv = s < 8 ? a.in[I_C][s * 1024 + k] : a.in[I_CCTX][k]; sl[i] = silu_(cv); }
        __syncthreads();
        float* MOD = (float*)(ws + WS_MOD);
        for (int u = vcu; u < 2 * 192; u += G) {
            const int l = u / 192, n0 = (u % 192) * 32, col = tid & 31, kg = tid >> 5;
            const float* w = a.in[I_ADAW] + (size_t)l * 1024 * 6144 + n0 + col;
            float acc[9];
#pragma unroll
            for (int s = 0; s < 9; ++s) acc[s] = 0.f;
#pragma unroll 4
            for (int kk = 0; kk < 64; ++kk) { const int k = kg * 64 + kk; const float wv = w[(size_t)k * 6144];
#pragma unroll
                for (int s = 0; s < 9; ++s) acc[s] += sl[s * 1024 + k] * wv; }
#pragma unroll
            for (int s = 0; s < 9; ++s) red[(kg * 9 + s) * 32 + col] = acc[s];
            __syncthreads();
            if (tid < 288) { const int s = tid >> 5, c2 = tid & 31; float t = a.in[I_ADAB][l * 6144 + n0 + c2];
#pragma unroll
                for (int q = 0; q < 16; ++q) t += red[(q * 9 + s) * 32 + c2];
                MOD[(size_t)(l * 9 + s) * 6144 + n0 + c2] = t; }
            __syncthreads();
        }
    }
    __syncthreads();
    for (int o = vcu * NT + tid; o < 131072; o += G * NT) { const int dgb = o >> 12, j = (o >> 6) & 63, i = o & 63; ((bf16*)(ws + WS_GWT))[o] = (bf16)f2bf(a.in[I_AGATEW][(size_t)dgb * 4096 + i * 64 + j]); }
    for (int o = vcu * NT + tid; o < 16384; o += G * NT) { const int n = 3072 + (o & 15), k = o >> 4; ((bf16*)(ws + WS_WIN0))[(size_t)n * 1024 + k] = (bf16)f2bf(a.in[I_EWIN][(size_t)k * E_IN + n]); }
    LAS float* scr = (LAS float*)(lds + wave * 16384);
    const int gw = vcu * NWAVES + wave, NGW = G * NWAVES;
    constexpr int I0 = 16 * 96, I1 = 16 * 32, I2 = 16 * 88, I3 = 16 * 88, I4 = 44 * 32, I5 = 16 * 129, I6 = 16 * 32;
    constexpr int NITEMS = I0 + I1 + I2 + I3 + I4 + I5 + I6;
    for (int it = gw; it < NITEMS; it += NGW) {
        int r = it;
        if (r < I0) { conv_mat_item(a.in[I_EWIN], E_IN, 1024, NU0, (bf16*)(ws + WS_WIN0), 0, r, scr, lane); continue; } r -= I0;
        if (r < I1) { conv_mat_item(a.in[I_EWOUT], 1024, 1024, 1024, (bf16*)(ws + WS_WOUT0), 0, r, scr, lane); continue; } r -= I1;
        if (r < I2) { conv_mat_item(a.in[I_EFG], DFF, 1024, DFF, (bf16*)(ws + WS_WGU0), 1, r, scr, lane); continue; } r -= I2;
        if (r < I3) { conv_mat_item(a.in[I_EFU], DFF, 1024, DFF, (bf16*)(ws + WS_WGU0), 2, r, scr, lane); continue; } r -= I3;
        if (r < I4) { conv_mat_item(a.in[I_EFD], 1024, DFF, 1024, (bf16*)(ws + WS_WDN0), 0, r, scr, lane); continue; } r -= I4;
        if (r < I5) { conv_mat_item(a.in[I_OWIN], O_IN, 1024, O_IN, (bf16*)(ws + WS_WIN1), 0, r, scr, lane); continue; } r -= I5;
        conv_mat_item(a.in[I_OWOUT], 1024, 1024, 1024, (bf16*)(ws + WS_WOUT1), 0, r, scr, lane);
    }
}
DI void moe_weight_copies(const Args& a, LAS unsigned char* lds, int vcu, int G) {
    const int tid = tid_fresh(), lane = tid & 63, wave = __builtin_amdgcn_readfirstlane(tid >> 6);
    LAS float* scr = (LAS float*)(lds + wave * 16384);
    const int gw = vcu * NWAVES + wave, NGW = G * NWAVES;
    constexpr int IG = 16 * 88, ID = 44 * 32, IE = 2 * IG + ID;
    for (int it = gw; it < NEXP * IE; it += NGW) {
        const int e = it / IE; int r = it - e * IE;
        bf16* gu = (bf16*)(a.ws + WS_WGU1) + (size_t)e * 5632 * 1024; bf16* dn = (bf16*)(a.ws + WS_WDN1) + (size_t)e * 1024 * DFF;
        if (r < IG) { conv_mat_item(a.in[I_MG] + (size_t)e * 1024 * DFF, DFF, 1024, DFF, gu, 1, r, scr, lane); continue; } r -= IG;
        if (r < IG) { conv_mat_item(a.in[I_MU] + (size_t)e * 1024 * DFF, DFF, 1024, DFF, gu, 2, r, scr, lane); continue; } r -= IG;
        conv_mat_item(a.in[I_MD] + (size_t)e * DFF * 1024, 1024, DFF, 1024, dn, 0, r, scr, lane);
    }
}

template <int WHICH> DI void norm_phase(const Args& a, LAS unsigned char* lds, int vcu, int G) {
    const int tid = tid_fresh(), lane = tid & 63, wave = __builtin_amdgcn_readfirstlane(tid >> 6);
    const int gw = vcu * NWAVES + wave, NGW = G * NWAVES;
    unsigned char* ws = a.ws;
    const float* MOD = (const float*)(ws + WS_MOD);
    constexpr int L = WHICH >= 2 ? 1 : 0, FF = (WHICH & 1), NROWS = WHICH == 3 ? ML : M0, NR = WHICH == 3 ? 2 : 3;
    const float* g = a.in[FF ? I_NFFN : I_NMIX] + L * 1024;
    LAS float* RWt = (LAS float*)lds;
    if (WHICH == 3) { for (int i = tid; i < 8192; i += NT) RWt[(i & 7) * 1024 + (i >> 3)] = a.in[I_RW][i]; __syncthreads(); }
    f32x4 gg[4];
#pragma unroll
    for (int j = 0; j < 4; ++j) gg[j] = *(const f32x4*)(g + 4 * lane + 256 * j);
    for (int rb = gw; rb < NROWS; rb += NR * NGW) {
        f32x4 v[NR][4]; float ss[NR];
#pragma unroll
        for (int q = 0; q < NR; ++q) { const int r = rb + q * NGW; ss[q] = 0.f;
            if (r < NROWS) { const bool lat = r < ML; const float* src;
                if (WHICH == 0) src = lat ? a.in[I_X] + (size_t)r * D : a.in[I_CTX] + (size_t)(r - ML) * D;
                else src = lat ? a.out + (size_t)r * D : (const float*)(ws + WS_HCTX) + (size_t)(r - ML) * D;
                const f32x4* xr = (const f32x4*)src + lane;
#pragma unroll
                for (int j = 0; j < 4; ++j) v[q][j] = xr[64 * j];
                if (WHICH == 1 && !lat) {
                    const f32x4* cr = (const f32x4*)(a.in[I_CTX] + (size_t)(r - ML) * D) + lane;
                    const f32x4* pr = (const f32x4*)((const float*)(ws + WS_PART0) + (size_t)(r - ML) * D) + lane;
#pragma unroll
                    for (int j = 0; j < 4; ++j) { v[q][j] = cr[64 * j];
#pragma unroll
                        for (int s4 = 0; s4 < 4; ++s4) v[q][j] += pr[(size_t)s4 * 2048 * 256 + 64 * j];
                        ((f32x4*)((float*)(ws + WS_HCTX) + (size_t)(r - ML) * D) + lane)[64 * j] = v[q][j]; } }
                if (WHICH == 2 && !lat) {
                    const f32x4* pr = (const f32x4*)((const float*)(ws + WS_PART0) + (size_t)(r - ML) * D) + lane;
#pragma unroll
                    for (int s8 = 0; s8 < 8; ++s8)
#pragma unroll
                        for (int j = 0; j < 4; ++j) v[q][j] += pr[(size_t)s8 * 2048 * 256 + 64 * j]; } } }
#pragma unroll
        for (int q = 0; q < NR; ++q) if (rb + q * NGW < NROWS) {
#pragma unroll
            for (int j = 0; j < 4; ++j) ss[q] += (v[q][j].x * v[q][j].x + v[q][j].y * v[q][j].y) + (v[q][j].z * v[q][j].z + v[q][j].w * v[q][j].w); }
#pragma unroll
        for (int q = 0; q < NR; ++q) ss[q] = wave_sum(ss[q]);
#pragma unroll
        for (int q = 0; q < NR; ++q) { const int r = rb + q * NGW;
            if (r < NROWS) { const bool lat = r < ML; const int s = lat ? (r >> 11) : 8;
                const float rstd = rsqrtf(ss[q] * (1.0f / D) + EPS);
                const float* shift = MOD + (size_t)(L * 9 + s) * 6144 + (FF ? 3 : 0) * 1024; const float* scale = shift + 1024;
                int rd = r;
                if (WHICH == 2 && lat) { const int t = r & 2047; rd = (r & ~2047) + (t & 63) * 32 + (t >> 6); }
                bf16* dst = (bf16*)(ws + (WHICH == 3 ? WS_XN2 : WS_XN)) + (size_t)rd * D;
#pragma unroll
                for (int j = 0; j < 4; ++j) { const int k = 4 * lane + 256 * j;
                    const f32x4 sh = *(const f32x4*)(shift + k), sc = *(const f32x4*)(scale + k);
                    v[q][j] = (v[q][j] * rstd) * gg[j] * (sc + 1.0f) + sh;
                    v2u o; o.x = pk2(v[q][j].x, v[q][j].y); o.y = pk2(v[q][j].z, v[q][j].w);
                    *(v2u*)(dst + k) = o; }
                if constexpr (WHICH == 3) {
                    float sm[8];
#pragma unroll
                    for (int n = 0; n < 8; ++n) { float acc = 0.f;
#pragma unroll
                        for (int j = 0; j < 4; ++j) { const f32x4 w = *(const LAS f32x4*)(RWt + n * 1024 + 4 * lane + 256 * j); acc += (v[q][j].x * w.x + v[q][j].y * w.y) + (v[q][j].z * w.z + v[q][j].w * w.w); }
                        sm[n] = acc; }
#pragma unroll
                    for (int n = 0; n < 8; ++n) sm[n] = wave_sum(sm[n]);
                    if (lane == 0) {
                        float lg[8];
#pragma unroll
                        for (int n = 0; n < 8; ++n) lg[n] = sm[n] + a.in[I_RB][n];
                        int e0 = 0; float v0 = lg[0];
#pragma unroll
                        for (int n = 1; n < 8; ++n) if (lg[n] > v0) { v0 = lg[n]; e0 = n; }
                        int e1 = -1; float v1 = -3.0e38f;
#pragma unroll
                        for (int n = 0; n < 8; ++n) if (n != e0 && lg[n] > v1) { v1 = lg[n]; e1 = n; }
                        const float p0 = 1.0f / (1.0f + expf(v1 - v0)), p1 = 1.0f - p0;
                        unsigned* ctl = (unsigned*)(ws + WS_CTL);
                        const unsigned s0 = atomicAdd(ctl + CW_CNT + 64 * e0, 1u), s1 = atomicAdd(ctl + CW_CNT + 64 * e1, 1u);
                        unsigned* tk = (unsigned*)(ws + WS_TOPK) + (size_t)r * 8;
                        tk[0] = (unsigned)e0; tk[1] = (unsigned)e1; tk[2] = __builtin_bit_cast(unsigned, p0); tk[3] = __builtin_bit_cast(unsigned, p1); tk[4] = s0; tk[5] = s1;
                    } }
            } }
    }
}


#define MFMA16(A_, B_, C_) __builtin_amdgcn_mfma_f32_16x16x32_bf16((A_), (B_), (C_), 0, 0, 0)
DI bf16x8 ldfrag(const LAS unsigned char* base, int stride, int r0, int k0, int lane) { return *(const LAS bf16x8*)(base + (r0 + (lane & 15)) * stride + (k0 + (lane >> 4) * 8) * 2); }


typedef short s16x4_t __attribute__((ext_vector_type(4)));
DI bf16x8 ldfrag_tr(const LAS unsigned char* base, int stride, int k0, int c0, int lane) {
    const LAS unsigned char* p = base + (k0 + 8 * (lane >> 4) + ((lane & 15) >> 2)) * stride + (c0 + 4 * (lane & 3)) * 2;
    const s16x4_t lo = __builtin_amdgcn_ds_read_tr16_b64_v4i16((LAS s16x4_t*)p), hi = __builtin_amdgcn_ds_read_tr16_b64_v4i16((LAS s16x4_t*)(p + 4 * stride));
    bf16x8 r; r[0] = lo[0]; r[1] = lo[1]; r[2] = lo[2]; r[3] = lo[3]; r[4] = hi[0]; r[5] = hi[1]; r[6] = hi[2]; r[7] = hi[3]; return r;
}

DI void scan1_prep_phase(const Args& a, LAS unsigned char* lds, int vcu, int G) {
    const int tid = tid_fresh(), lane = tid & 63, wave = __builtin_amdgcn_readfirstlane(tid >> 6);
    unsigned char* ws = a.ws;
    const bf16* U = (const bf16*)(ws + WS_U);
    constexpr int IMG = 64 * 272;
    LAS unsigned char* QDs = lds;
    LAS unsigned char* KDs = lds + 2 * IMG;
    LAS unsigned char* KTs = lds + 4 * IMG;
    LAS float* tot = (LAS float*)(lds + 6 * IMG);
    const float* lbl = a.in[I_LBLOG];
    for (int u = vcu; u < 2304; u += G) {
        int r = u; const int chunk = r % 36; r /= 36; const int h = r & 3; r >>= 2; const int b = r & 7; const int type = r >> 3;
        const int DKS = type ? 6 : 7, DK = 1 << DKS;
        const int row0 = chunk < 4 ? ML + b * CTXL + chunk * 64 : b * SEQ + (chunk - 4) * 64;
        const bool lat = chunk >= 4;
        LDS_BARRIER();
        if (type == 0) {
            const int cc = h * 128 + 2 * lane;
            const float lb0 = frcp(1.0f + __expf(lbl[cc] - lbl[512 + cc])), lb1 = frcp(1.0f + __expf(lbl[cc + 1] - lbl[512 + cc + 1]));
            unsigned ufl[2][8], uq[8];
#pragma unroll
            for (int i = 0; i < 8; ++i) { const bf16* ur = U + (size_t)(row0 + wave * 8 + i) * NU1S; ufl[0][i] = *(const unsigned*)(ur + 512 + cc); ufl[1][i] = *(const unsigned*)(ur + 1024 + cc); uq[i] = lat ? *(const unsigned*)(ur + cc) : 0u; }
            float E0[2][8], E1[2][8], k0[2][8], k1[2][8];
#pragma unroll
            for (int d = 0; d < 2; ++d) {
#pragma unroll
                for (int i = 0; i < 8; ++i) { const float s0 = sigm(bflo(ufl[d][i])), s1 = sigm(bfhi(ufl[d][i]));
                    E0[d][i] = lb0 + (1.0f - lb0) * s0; E1[d][i] = lb1 + (1.0f - lb1) * s1; k0[d][i] = (1.0f - lb0) * (1.0f - s0); k1[d][i] = (1.0f - lb1) * (1.0f - s1); }
                if (d == 0) {
#pragma unroll
                    for (int i = 1; i < 8; ++i) { E0[0][i] *= E0[0][i - 1]; E1[0][i] *= E1[0][i - 1]; }
                    tot[wave * 128 + 2 * lane] = E0[0][7]; tot[wave * 128 + 2 * lane + 1] = E1[0][7];
                } else {
#pragma unroll
                    for (int i = 6; i >= 0; --i) { E0[1][i] *= E0[1][i + 1]; E1[1][i] *= E1[1][i + 1]; }
                    tot[2048 + wave * 128 + 2 * lane] = E0[1][0]; tot[2048 + wave * 128 + 2 * lane + 1] = E1[1][0];
                }
            }
            LDS_BARRIER();
            float q0[8], q1[8];
#pragma unroll
            for (int i = 0; i < 8; ++i) { q0[i] = silu_(bflo(uq[i])) * 0.08838834764831845f; q1[i] = silu_(bfhi(uq[i])) * 0.08838834764831845f; }
#pragma unroll
            for (int d = 0; d < 2; ++d) {
                float pre0 = 1.f, pre1 = 1.f, all0 = 1.f, all1 = 1.f;
#pragma unroll
                for (int w = 0; w < 8; ++w) { const float t0 = tot[d * 2048 + w * 128 + 2 * lane], t1 = tot[d * 2048 + w * 128 + 2 * lane + 1]; all0 *= t0; all1 *= t1;
                    const bool before = d ? (w > wave) : (w < wave); pre0 *= before ? t0 : 1.f; pre1 *= before ? t1 : 1.f; }
#pragma unroll
                for (int i = 0; i < 8; ++i) { const int c = wave * 8 + i;
                    const float e0 = pre0 * E0[d][i], e1 = pre1 * E1[d][i], r0 = frcp(e0), r1 = frcp(e1);
                    *(LAS unsigned*)(QDs + d * IMG + c * 272 + lane * 4) = pk2(q0[i] * e0, q1[i] * e1);
                    *(LAS unsigned*)(KDs + d * IMG + c * 272 + lane * 4) = pk2(k0[d][i] * r0, k1[d][i] * r1);
                    *(LAS unsigned*)(KTs + d * IMG + c * 272 + lane * 4) = pk2(k0[d][i] * all0 * r0, k1[d][i] * all1 * r1); }
                if (wave == 0) { float* dt = (float*)(ws + WS_DT1) + (size_t)(((b * 4 + h) * 2 + d) * 36 + chunk) * 128 + 2 * lane; dt[0] = all0; dt[1] = all1; }
            }
        } else {
            const int cp = tid & 31, tg = tid >> 5, cc = h * 64 + 2 * cp;
            float lf0[2][4], lf1[2][4], k0[4], k1[4], q0[4], q1[4];
            v4u lrv[4][4];
#pragma unroll
            for (int i = 0; i < 4; ++i) { const bf16* ur = U + (size_t)(row0 + tg * 4 + i) * NU1S;
#pragma unroll
                for (int p = 0; p < 4; ++p) lrv[i][p] = *(const v4u*)(ur + 4096 + 8 * p);
                const unsigned uk = *(const unsigned*)(ur + 2816 + cc), uqv = lat ? *(const unsigned*)(ur + 2560 + cc) : 0u;
                k0[i] = bflo(uk); k1[i] = bfhi(uk); q0[i] = bflo(uqv) * 0.125f; q1[i] = bfhi(uqv) * 0.125f; }
#pragma unroll
            for (int d = 0; d < 2; ++d) {
                float w2a[16], w2b[16];
#pragma unroll
                for (int rr = 0; rr < 16; ++rr) { w2a[rr] = a.in[I_DGW2][(d * 16 + rr) * 256 + cc]; w2b[rr] = a.in[I_DGW2][(d * 16 + rr) * 256 + cc + 1]; }
                const float bz0 = a.in[I_DGB2][d * 256 + cc], bz1 = a.in[I_DGB2][d * 256 + cc + 1];
#pragma unroll
                for (int i = 0; i < 4; ++i) { const v4u la = lrv[i][2 * d], lbv = lrv[i][2 * d + 1];
                    const float lr[16] = {bflo(la.x), bfhi(la.x), bflo(la.y), bfhi(la.y), bflo(la.z), bfhi(la.z), bflo(la.w), bfhi(la.w), bflo(lbv.x), bfhi(lbv.x), bflo(lbv.y), bfhi(lbv.y), bflo(lbv.z), bfhi(lbv.z), bflo(lbv.w), bfhi(lbv.w)};
                    float z0 = bz0, z1 = bz1;
#pragma unroll
                    for (int rr = 0; rr < 16; ++rr) { z0 += lr[rr] * w2a[rr]; z1 += lr[rr] * w2b[rr]; }
                    lf0[d][i] = -softplus_fast(-z0) * (1.0f / 16.0f); lf1[d][i] = -softplus_fast(-z1) * (1.0f / 16.0f); }
                if (d == 0) {
#pragma unroll
                    for (int i = 1; i < 4; ++i) { lf0[0][i] += lf0[0][i - 1]; lf1[0][i] += lf1[0][i - 1]; }
                    tot[tg * 128 + 2 * cp] = lf0[0][3]; tot[tg * 128 + 2 * cp + 1] = lf1[0][3];
                } else {
#pragma unroll
                    for (int i = 2; i >= 0; --i) { lf0[1][i] += lf0[1][i + 1]; lf1[1][i] += lf1[1][i + 1]; }
                    tot[2048 + tg * 128 + 2 * cp] = lf0[1][0]; tot[2048 + tg * 128 + 2 * cp + 1] = lf1[1][0];
                }
            }
            LDS_BARRIER();
#pragma unroll
            for (int d = 0; d < 2; ++d) {
                float pre0 = 0.f, pre1 = 0.f, all0 = 0.f, all1 = 0.f;
#pragma unroll
                for (int w = 0; w < 16; ++w) { const float t0 = tot[d * 2048 + w * 128 + 2 * cp], t1 = tot[d * 2048 + w * 128 + 2 * cp + 1]; all0 += t0; all1 += t1;
                    const bool before = d ? (w > tg) : (w < tg); pre0 += before ? t0 : 0.f; pre1 += before ? t1 : 0.f; }
                const float el0 = __expf(all0), el1 = __expf(all1);
#pragma unroll
                for (int i = 0; i < 4; ++i) { const int c = tg * 4 + i;
                    const float e0 = __expf(pre0 + lf0[d][i]), e1 = __expf(pre1 + lf1[d][i]), r0 = frcp(e0), r1 = frcp(e1);
                    *(LAS unsigned*)(QDs + d * IMG + c * 272 + cp * 4) = pk2(q0[i] * e0, q1[i] * e1);
                    *(LAS unsigned*)(KDs + d * IMG + c * 272 + cp * 4) = pk2(k0[i] * r0, k1[i] * r1);
                    *(LAS unsigned*)(KTs + d * IMG + c * 272 + cp * 4) = pk2(k0[i] * el0 * r0, k1[i] * el1 * r1); }
                if (tg == 0) { float* dt = (float*)(ws + WS_DT1) + (size_t)((64 + (b * 4 + h) * 2 + d) * 36 + chunk) * 128 + 2 * cp; dt[0] = el0; dt[1] = el1; }
            }
        }
        LDS_BARRIER();
#pragma unroll
        for (int d = 0; d < 2; ++d) {
            const int cidT = (b * 4 + h) * 2 + d, cid = type * 64 + cidT;
            { v4u* KTg = (v4u*)(type ? ws + WS_KTG : ws + WS_KTH) + (size_t)(cidT * 36 + chunk) * (DK * 8);
              for (int i = tid; i < DK * 8; i += NT) { const int c = i >> (DKS - 3), kk = (i & ((DK >> 3) - 1)) * 8; KTg[i] = *(const LAS v4u*)(KTs + d * IMG + c * 272 + kk * 2); } }
            if (lat) {
                const int lc = chunk - 4;
                { v4u* QDg = (v4u*)(type ? ws + WS_QDG : ws + WS_QDH) + (size_t)(cidT * 32 + lc) * (DK * 8);
                  for (int i = tid; i < DK * 8; i += NT) { const int c = i >> (DKS - 3), kk = (i & ((DK >> 3) - 1)) * 8; QDg[i] = *(const LAS v4u*)(QDs + d * IMG + c * 272 + kk * 2); } }
                const int mt = wave >> 1, nts = (wave & 1) * 2;
                f32x4 acc0 = {0.f, 0.f, 0.f, 0.f}, acc1 = {0.f, 0.f, 0.f, 0.f};
                for (int ks = 0; ks < (DK >> 5); ++ks) { const bf16x8 fa = ldfrag(QDs + d * IMG, 272, mt * 16, ks * 32, lane), fb0 = ldfrag(KDs + d * IMG, 272, nts * 16, ks * 32, lane), fb1 = ldfrag(KDs + d * IMG, 272, nts * 16 + 16, ks * 32, lane);
                    acc0 = MFMA16(fa, fb0, acc0); acc1 = MFMA16(fa, fb1, acc1); }
                bf16* Ag = (bf16*)(ws + WS_A1) + (size_t)(cid * 32 + lc) * 4096;
#pragma unroll
                for (int i = 0; i < 4; ++i) { const int c = mt * 16 + (lane >> 4) * 4 + i, j0 = nts * 16 + (lane & 15), j1 = j0 + 16;
                    const bool kp0 = d ? (j0 >= c) : (j0 <= c), kp1 = d ? (j1 >= c) : (j1 <= c);
                    Ag[c * 64 + j0] = (bf16)f2bf(kp0 ? acc0[i] : 0.f); Ag[c * 64 + j1] = (bf16)f2bf(kp1 ? acc1[i] : 0.f); }
            }
        }
    }
}

template <int TYPE> DI void scan1_chain_unit(const Args& a, LAS unsigned char* lds, int u) {
    const int tid = tid_fresh(), lane = tid & 63, wave = __builtin_amdgcn_readfirstlane(tid >> 6);
    unsigned char* ws = a.ws;
    const bf16* U = (const bf16*)(ws + WS_U);
    constexpr int BUFSZ = 54784, O_QD = 0, O_KT = 17408, O_A = 35840, O_VT = 45056, O_DT = 54272, O_ST = 2 * BUFSZ, STSZ = 17408;
    {
        constexpr int type = TYPE; const int rem = u & 127, b = rem >> 4, h = (rem >> 2) & 3, d = (rem >> 1) & 1, sl = rem & 1;
        constexpr int DKS = type ? 6 : 7, DK = 1 << DKS; const int cidT = (b * 4 + h) * 2 + d, cid = type * 64 + cidT;
        const int vcol = (type ? 3072 : 1536) + h * 128 + sl * 64;
        const v4u* QDg = (const v4u*)(type ? ws + WS_QDG : ws + WS_QDH) + (size_t)cidT * 32 * (DK * 8);
        const v4u* KTg = (const v4u*)(type ? ws + WS_KTG : ws + WS_KTH) + (size_t)cidT * 36 * (DK * 8);
        const v4u* Ag = (const v4u*)(ws + WS_A1) + (size_t)cid * 32 * 512;
        const float* DTg = (const float*)(ws + WS_DT1) + (size_t)cid * 36 * 128;
        bf16* Og = (bf16*)(ws + WS_O1) + (size_t)d * ML * 1024 + type * 512 + h * 128 + sl * 64;
        constexpr int NTL = type ? 2 : 4;
        f32x4 S[4];
#pragma unroll
        for (int i = 0; i < 4; ++i) S[i] = (f32x4){0.f, 0.f, 0.f, 0.f};
        LDS_BARRIER();
        for (int i = tid; i < STSZ / 4; i += NT) ((LAS unsigned*)(lds + O_ST))[i] = 0u;
        v4u rq[2], rk[2], ra, rv; f32x4 rd;
#define chunk_of(n_) ((n_) < 4 ? (d ? 3 - (n_) : (n_)) : 4 + (d ? 31 - ((n_) - 4) : (n_) - 4))
#define S1_LOAD(n_) do { const int ck_ = chunk_of(n_); const bool lat_ = ck_ >= 4; \
            const size_t row0_ = lat_ ? (size_t)b * SEQ + (ck_ - 4) * 64 : (size_t)ML + b * CTXL + ck_ * 64; \
            rk[0] = KTg[(size_t)ck_ * (DK * 8) + tid]; if (type == 0) rk[1] = KTg[(size_t)ck_ * (DK * 8) + 512 + tid]; \
            rv = *(const v4u*)(U + (row0_ + lane) * NU1S + vcol + wave * 8); \
            if (tid < 32) rd = *(const f32x4*)(DTg + (size_t)ck_ * 128 + tid * 4); \
            if (lat_) { rq[0] = QDg[(size_t)(ck_ - 4) * (DK * 8) + tid]; if (type == 0) rq[1] = QDg[(size_t)(ck_ - 4) * (DK * 8) + 512 + tid]; ra = Ag[(size_t)(ck_ - 4) * 512 + tid]; } } while (0)
#define S1_STORE(n_, buf_) do { LAS unsigned char* B_ = lds + (buf_) * BUFSZ; const bool lat_ = (n_) >= 4; \
            if (type == 0) { const int c_ = tid >> 4, kk_ = (tid & 15) * 8; *(LAS v4u*)(B_ + O_KT + c_ * 272 + kk_ * 2) = rk[0]; *(LAS v4u*)(B_ + O_KT + (c_ + 32) * 272 + kk_ * 2) = rk[1]; } \
            else { const int c_ = tid >> 3, kk_ = (tid & 7) * 8; *(LAS v4u*)(B_ + O_KT + c_ * 272 + kk_ * 2) = rk[0]; } \
            *(LAS v4u*)(B_ + O_VT + lane * 144 + wave * 16) = rv; \
            if (tid < 32) *(LAS f32x4*)(B_ + O_DT + tid * 16) = rd; \
            if (lat_) { if (type == 0) { const int c_ = tid >> 4, kk_ = (tid & 15) * 8; *(LAS v4u*)(B_ + O_QD + c_ * 272 + kk_ * 2) = rq[0]; *(LAS v4u*)(B_ + O_QD + (c_ + 32) * 272 + kk_ * 2) = rq[1]; } \
                        else { const int c_ = tid >> 3, kk_ = (tid & 7) * 8; *(LAS v4u*)(B_ + O_QD + c_ * 272 + kk_ * 2) = rq[0]; } \
                        { const int c_ = tid >> 3, jj_ = (tid & 7) * 8; *(LAS v4u*)(B_ + O_A + c_ * 144 + jj_ * 2) = ra; } } } while (0)
        S1_LOAD(0); S1_STORE(0, 0);
        LDS_BARRIER();
        for (int n = 0; n < 36; ++n) {
            const int cur = n & 1, nxt = cur ^ 1; const bool lat = n >= 4;
            const LAS unsigned char* Bc = lds + cur * BUFSZ; const LAS unsigned char* Stc = lds + O_ST + cur * STSZ;
            if (n + 1 < 36) S1_LOAD(n + 1);
            if (lat) {
                const int mt = wave >> 1, nts = (wave & 1) * 2;
                f32x4 o0 = {0.f, 0.f, 0.f, 0.f}, o1 = {0.f, 0.f, 0.f, 0.f};
#pragma unroll
                for (int ks = 0; ks < (DK >> 5); ++ks) { const bf16x8 fa = ldfrag(Bc + O_QD, 272, mt * 16, ks * 32, lane), fb0 = ldfrag(Stc, 272, nts * 16, ks * 32, lane), fb1 = ldfrag(Stc, 272, nts * 16 + 16, ks * 32, lane);
                    o0 = MFMA16(fa, fb0, o0); o1 = MFMA16(fa, fb1, o1); }
#pragma unroll
                for (int ks = 0; ks < 2; ++ks) { const bf16x8 fa = ldfrag(Bc + O_A, 144, mt * 16, ks * 32, lane), fb0 = ldfrag_tr(Bc + O_VT, 144, ks * 32, nts * 16, lane), fb1 = ldfrag_tr(Bc + O_VT, 144, ks * 32, nts * 16 + 16, lane);
                    o0 = MFMA16(fa, fb0, o0); o1 = MFMA16(fa, fb1, o1); }
                const int ck = chunk_of(n); const size_t row0 = (size_t)b * SEQ + (ck - 4) * 64;
#pragma unroll
                for (int i = 0; i < 4; ++i) { bf16* op = Og + (row0 + mt * 16 + (lane >> 4) * 4 + i) * 1024 + nts * 16 + (lane & 15); op[0] = (bf16)f2bf(o0[i]); op[16] = (bf16)f2bf(o1[i]); }
            }
#pragma unroll
            for (int i = 0; i < 4; ++i) if (i < NTL) {
                const int t = wave * NTL + i, kt = t >> 2, nt = t & 3;
                const f32x4 dt = *(const LAS f32x4*)(Bc + O_DT + (kt * 16 + (lane >> 4) * 4) * 4);
                f32x4 s = S[i] * dt;
#pragma unroll
                for (int ks = 0; ks < 2; ++ks) { const bf16x8 fa = ldfrag_tr(Bc + O_KT, 272, ks * 32, kt * 16, lane), fb = ldfrag_tr(Bc + O_VT, 144, ks * 32, nt * 16, lane); s = MFMA16(fa, fb, s); }
                S[i] = s;
            }
#pragma unroll
            for (int i = 0; i < 4; ++i) if (i < NTL) {
                const int t = wave * NTL + i, kt = t >> 2, nt = t & 3;
                v2u p; p.x = pk2(S[i][0], S[i][1]); p.y = pk2(S[i][2], S[i][3]);
                *(LAS v2u*)(lds + O_ST + nxt * STSZ + (nt * 16 + (lane & 15)) * 272 + (kt * 16 + (lane >> 4) * 4) * 2) = p;
            }
            if (n + 1 < 36) S1_STORE(n + 1, nxt);
            LDS_BARRIER();
        }
#undef S1_LOAD
#undef chunk_of
#undef S1_STORE
    }
}

DI void scan1_chain_phase(const Args& a, LAS unsigned char* lds, int vcu, int G) {
    for (int u = vcu; u < 256; u += G) { if (u < 128) scan1_chain_unit<0>(a, lds, u); else scan1_chain_unit<1>(a, lds, u); }
}


DI void dn_prep_unit(const Args& a, LAS unsigned char* lds, int u) {
    const int tid = tid_fresh(), lane = tid & 63, wave = __builtin_amdgcn_readfirstlane(tid >> 6);
    unsigned char* ws = a.ws;
    const bf16* U = (const bf16*)(ws + WS_U); const float* cw = a.in[I_BCONVW];
    LAS unsigned char* Qs = lds;
    LAS unsigned char* Ks = lds + 17408;
    LAS float* KK = (LAS float*)(lds + 34816);
    LAS float* QK = KK + 64 * 65;
    LAS float* Ls = QK + 64 * 65;
    LAS unsigned char* Tn = (LAS unsigned char*)(Ls + 8192);
    LAS float* g_s = (LAS float*)(Tn + 2 * 9216);
    LAS float* be_s = g_s + 128;
    const int chunk = u % 36, bh = u / 36, b = bh >> 2, h = bh & 3;
    const int row0 = chunk < 4 ? ML + b * CTXL + chunk * 64 : b * SEQ + (chunk - 4) * 64;
    const int seg0 = chunk < 4 ? ML + b * CTXL : b * SEQ, len = chunk < 4 ? CTXL : SEQ;
    LDS_BARRIER();
#if defined(SUBP) && SUBP == 3
    for (int rp_ = 0; rp_ < 2; ++rp_)
#endif
    {
        float cwv[3][4][2];
#pragma unroll
        for (int part = 0; part < 3; ++part)
#pragma unroll
            for (int j = 0; j < 4; ++j) { const int c0 = part * 512 + h * 128 + 2 * lane; cwv[part][j][0] = cw[j * 1536 + c0]; cwv[part][j][1] = cw[j * 1536 + c0 + 1]; }
        unsigned xs[11][3];
        const int tb = row0 - seg0 + wave * 8 - 2;
#pragma unroll
        for (int i = 0; i < 11; ++i) { const int tt = tb + i; const bool ok = tt >= 0 && tt < len;
#pragma unroll
            for (int part = 0; part < 3; ++part) xs[i][part] = ok ? *(const unsigned*)(U + (size_t)(seg0 + tt) * NU0S + 1024 + part * 512 + h * 128 + 2 * lane) : 0u; }
#pragma unroll
        for (int i = 0; i < 8; ++i) {
            const int c = wave * 8 + i, r = row0 + c;
            float val[3][2];
#pragma unroll
            for (int part = 0; part < 3; ++part) { float a0 = 0.f, a1 = 0.f;
#pragma unroll
                for (int j = 0; j < 4; ++j) { a0 += cwv[part][j][0] * bflo(xs[i + j][part]); a1 += cwv[part][j][1] * bfhi(xs[i + j][part]); }
                val[part][0] = silu_(a0); val[part][1] = silu_(a1); }
            const float sq = wave_sum(val[0][0] * val[0][0] + val[0][1] * val[0][1]), sk = wave_sum(val[1][0] * val[1][0] + val[1][1] * val[1][1]);
            const float fq = rsqrtf(sq + EPS) * 0.08838834764831845f, fk = rsqrtf(sk + EPS);
            const size_t o = (size_t)r * 512 + h * 128 + 2 * lane;
            const unsigned pq = pk2(val[0][0] * fq, val[0][1] * fq), pk = pk2(val[1][0] * fk, val[1][1] * fk);
            *(unsigned*)((bf16*)(ws + WS_DNQ) + o) = pq; *(unsigned*)((bf16*)(ws + WS_DNK) + o) = pk;
            *(unsigned*)((bf16*)(ws + WS_DNV) + o) = pk2(val[2][0], val[2][1]);
            *(LAS unsigned*)(Qs + c * 272 + lane * 4) = pq; *(LAS unsigned*)(Ks + c * 272 + lane * 4) = pk;
        }
    }
    if (tid < 128) { const int d = tid >> 6, c = tid & 63; const bf16* ur = U + (size_t)(row0 + c) * NU0S + 3072;
        be_s[tid] = sigm(bf2f(ur[d * 4 + h]));
        g_s[tid] = -__expf(a.in[I_BALOG][d * 4 + h]) * softplus_fast(bf2f(ur[8 + d * 4 + h]) + a.in[I_BDT][d * 4 + h]); }
    LDS_BARRIER();
    {
        const int mt = wave >> 1, nts = (wave & 1) * 2;
        f32x4 kk0 = {0.f, 0.f, 0.f, 0.f}, kk1 = kk0, qk0 = kk0, qk1 = kk0;
#pragma unroll
        for (int ks = 0; ks < 4; ++ks) { const bf16x8 fk = ldfrag(Ks, 272, mt * 16, ks * 32, lane), fq = ldfrag(Qs, 272, mt * 16, ks * 32, lane), fb0 = ldfrag(Ks, 272, nts * 16, ks * 32, lane), fb1 = ldfrag(Ks, 272, nts * 16 + 16, ks * 32, lane);
            kk0 = MFMA16(fk, fb0, kk0); kk1 = MFMA16(fk, fb1, kk1); qk0 = MFMA16(fq, fb0, qk0); qk1 = MFMA16(fq, fb1, qk1); }
#pragma unroll
        for (int i = 0; i < 4; ++i) { const int ri = mt * 16 + (lane >> 4) * 4 + i, cj = nts * 16 + (lane & 15);
            KK[ri * 65 + cj] = kk0[i]; KK[ri * 65 + cj + 16] = kk1[i]; QK[ri * 65 + cj] = qk0[i]; QK[ri * 65 + cj + 16] = qk1[i]; }
    }
    float gcv = 0.f;
    if (wave < 2) { const int d = wave, c = d ? 63 - lane : lane; float x = g_s[d * 64 + c];
#pragma unroll
        for (int o = 1; o < 64; o <<= 1) { const float y = __shfl_up(x, o); if (lane >= o) x += y; }
        gcv = x; }
    LDS_BARRIER();
    if (wave < 2) { const int d = wave, c = d ? 63 - lane : lane; g_s[d * 64 + c] = gcv; }
    LDS_BARRIER();
    const size_t ud = (size_t)bh * 36 + chunk;
    LAS unsigned char* L21i = (LAS unsigned char*)(be_s + 128);
    LAS unsigned char* T11T = L21i + 5120;
    LAS unsigned char* T22i = T11T + 5120;
    LAS unsigned char* MTi = T22i + 5120;
    for (int i = tid; i < 2 * 9216 / 4; i += NT) ((LAS unsigned*)Tn)[i] = 0u;
    for (int idx = tid; idx < 2048; idx += NT) { const int d = idx >> 10, i = (idx >> 4) & 63, j4 = (idx & 15) * 4, ni = d ? 63 - i : i;
        const float gi = g_s[d * 64 + ni], bi = be_s[d * 64 + ni];
        float lv[4], av[4];
#pragma unroll
        for (int jj = 0; jj < 4; ++jj) { const int j = j4 + jj, nj = d ? 63 - j : j;
            const float e = __expf(fminf(gi - g_s[d * 64 + nj], 0.f));
            lv[jj] = (j < i) ? bi * KK[ni * 65 + nj] * e : 0.f; av[jj] = (j <= i) ? QK[ni * 65 + nj] * e : 0.f; }
        *(LAS f32x4*)(Ls + d * 4096 + i * 64 + j4) = (f32x4){lv[0], lv[1], lv[2], lv[3]};
        if (i >= 32 && j4 < 32) { v2u p; p.x = pk2(lv[0], lv[1]); p.y = pk2(lv[2], lv[3]); *(LAS v2u*)(L21i + d * 2560 + (i - 32) * 80 + j4 * 2) = p; }
        bf16* ag = (bf16*)(ws + WS_DNA) + ((size_t)d * 32 * 36 + ud) * 4096 + ni * 64;
        v2u q; if (d == 0) { q.x = pk2(av[0], av[1]); q.y = pk2(av[2], av[3]); *(v2u*)(ag + j4) = q; } else { q.x = pk2(av[3], av[2]); q.y = pk2(av[1], av[0]); *(v2u*)(ag + 60 - j4) = q; } }
    if (tid < 128) { const int d = tid >> 6, c = tid & 63; const float gl = g_s[d * 64 + (d ? 0 : 63)], gc = g_s[tid];
        float* vp = (float*)(ws + WS_DNVEC) + ((size_t)d * 32 * 36 + ud) * 256;
        vp[c] = __expf(gc); vp[64 + c] = be_s[tid]; vp[128 + c] = __expf(gl - gc); vp[192 + c] = __expf(gl); }
    LDS_BARRIER();
    if (wave < 4) {
        const int d = wave >> 1, blk = wave & 1; int c = lane & 31; asm volatile("" : "+v"(c));
        const LAS float* Lb = Ls + d * 4096 + (blk * 32) * 64 + blk * 32;
        float t[32];
        f32x4 cur[8], nxt[8];
        cur[0] = *(const LAS f32x4*)(Lb + 1 * 64);
        t[0] = (c == 0) ? 1.0f : 0.0f;
#pragma unroll
        for (int i = 1; i < 32; ++i) {
            if (i + 1 < 32) {
#pragma unroll
                for (int j4 = 0; j4 < (i + 1 + 3) / 4; ++j4) nxt[j4] = *(const LAS f32x4*)(Lb + (i + 1) * 64 + j4 * 4);
            }
            float acc0 = (i == c) ? 1.0f : 0.0f, acc1 = 0.f, acc2 = 0.f, acc3 = 0.f;
#pragma unroll
            for (int j4 = 0; j4 < (i + 3) / 4; ++j4) {
                if (j4 * 4 + 0 < i) acc0 -= cur[j4].x * t[j4 * 4 + 0];
                if (j4 * 4 + 1 < i) acc1 -= cur[j4].y * t[j4 * 4 + 1];
                if (j4 * 4 + 2 < i) acc2 -= cur[j4].z * t[j4 * 4 + 2];
                if (j4 * 4 + 3 < i) acc3 -= cur[j4].w * t[j4 * 4 + 3]; }
            t[i] = (acc0 + acc1) + (acc2 + acc3);
#pragma unroll
            for (int j4 = 0; j4 < 8; ++j4) cur[j4] = nxt[j4];
        }
        if (lane < 32) {
            const int nc = d ? 63 - (blk * 32 + c) : blk * 32 + c;
#pragma unroll
            for (int i = 0; i < 32; ++i) { const int ni = d ? 63 - (blk * 32 + i) : blk * 32 + i; *(LAS bf16*)(Tn + d * 9216 + ni * 144 + nc * 2) = (bf16)f2bf(t[i]); }
            if (blk == 0) {
#pragma unroll
                for (int i = 0; i < 32; i += 2) *(LAS unsigned*)(T11T + d * 2560 + c * 80 + i * 2) = pk2(t[i], t[i + 1]);
            } else {
#pragma unroll
                for (int i = 0; i < 32; ++i) *(LAS bf16*)(T22i + d * 2560 + i * 80 + c * 2) = (bf16)f2bf(t[i]);
            }
        }
    }
    LDS_BARRIER();
    { const int d = wave >> 2, mt = (wave >> 1) & 1, nt = wave & 1;
      const f32x4 z4 = {0.f, 0.f, 0.f, 0.f};
      const f32x4 m = MFMA16(ldfrag(L21i + d * 2560, 80, mt * 16, 0, lane), ldfrag(T11T + d * 2560, 80, nt * 16, 0, lane), z4);
      v2u p; p.x = pk2(m[0], m[1]); p.y = pk2(m[2], m[3]);
      *(LAS v2u*)(MTi + d * 2560 + (nt * 16 + (lane & 15)) * 80 + (mt * 16 + (lane >> 4) * 4) * 2) = p; }
    LDS_BARRIER();
    { const int d = wave >> 2, mt = (wave >> 1) & 1, nt = wave & 1;
      const f32x4 z4 = {0.f, 0.f, 0.f, 0.f};
      const f32x4 m = MFMA16(ldfrag(T22i + d * 2560, 80, mt * 16, 0, lane), ldfrag(MTi + d * 2560, 80, nt * 16, 0, lane), z4);
      const int j = nt * 16 + (lane & 15), nj = d ? 63 - j : j;
#pragma unroll
      for (int ii = 0; ii < 4; ++ii) { const int i = 32 + mt * 16 + (lane >> 4) * 4 + ii, ni = d ? 63 - i : i; *(LAS bf16*)(Tn + d * 9216 + ni * 144 + nj * 2) = (bf16)f2bf(-m[ii]); } }
    LDS_BARRIER();
    for (int p = tid; p < 1024; p += NT) { const int d = p >> 9, q = p & 511, c = q >> 3, jj = (q & 7) * 8;
        ((v4u*)(ws + WS_DNT))[((size_t)d * 32 * 36 + ud) * 512 + q] = *(const LAS v4u*)(Tn + d * 9216 + c * 144 + jj * 2); }
}

DI void dn_chain_phase(const Args& a, LAS unsigned char* lds, int vcu, int G) {
    const int tid = tid_fresh(), lane = tid & 63, wave = __builtin_amdgcn_readfirstlane(tid >> 6);
    unsigned char* ws = a.ws;
    constexpr int BUF = 58368, O_Q = 0, O_K = 17408, O_T = 34816, O_A = 44032, O_V = 53248, O_VEC = 57344, O_ST = 2 * BUF, O_RT = O_ST + 8704, O_VN = O_RT + 4608, O_VW = O_VN + 4608;
    for (int u = vcu; u < 256; u += G) {
        const int b = u >> 5, h = (u >> 3) & 3, d = (u >> 2) & 1, sl = u & 3, bh = b * 4 + h;
        const bf16* Qg = (const bf16*)(ws + WS_DNQ) + h * 128; const bf16* Kg = (const bf16*)(ws + WS_DNK) + h * 128; const bf16* Vg = (const bf16*)(ws + WS_DNV) + h * 128 + sl * 32;
        const v4u* Tg = (const v4u*)(ws + WS_DNT) + ((size_t)d * 32 + bh) * 36 * 512; const v4u* Ag = (const v4u*)(ws + WS_DNA) + ((size_t)d * 32 + bh) * 36 * 512;
        const f32x4* Vecg = (const f32x4*)(ws + WS_DNVEC) + ((size_t)d * 32 + bh) * 36 * 64;
        bf16* Og = (bf16*)(ws + WS_DNO) + (size_t)d * M0 * 512 + h * 128 + sl * 32;
        f32x4 S0 = {0.f, 0.f, 0.f, 0.f}, S1 = S0;
        LDS_BARRIER();
        for (int i = tid; i < 8704 / 4; i += NT) ((LAS unsigned*)(lds + O_ST))[i] = 0u;
        v4u rq[2], rk[2], rt, ra, rv; f32x4 rvec;
#define chunk_of(n_) ((n_) < 4 ? (d ? 3 - (n_) : (n_)) : 4 + (d ? 31 - ((n_) - 4) : (n_) - 4))
#define DN_LOAD(n_) do { const int ck_ = chunk_of(n_); const size_t row0_ = ck_ < 4 ? (size_t)ML + b * CTXL + ck_ * 64 : (size_t)b * SEQ + (ck_ - 4) * 64; \
            { const int c_ = tid >> 4, kk_ = (tid & 15) * 8; rq[0] = *(const v4u*)(Qg + (row0_ + c_) * 512 + kk_); rq[1] = *(const v4u*)(Qg + (row0_ + c_ + 32) * 512 + kk_); \
              rk[0] = *(const v4u*)(Kg + (row0_ + c_) * 512 + kk_); rk[1] = *(const v4u*)(Kg + (row0_ + c_ + 32) * 512 + kk_); } \
            rt = Tg[(size_t)ck_ * 512 + tid]; ra = Ag[(size_t)ck_ * 512 + tid]; \
            if (tid < 256) rv = *(const v4u*)(Vg + (row0_ + (tid >> 2)) * 512 + (tid & 3) * 8); \
            if (tid < 64) rvec = Vecg[(size_t)ck_ * 64 + tid]; } while (0)
#define DN_STORE(SB_) do { { const int c_ = tid >> 4, kk_ = (tid & 15) * 8; *(LAS v4u*)((SB_) + O_Q + c_ * 272 + kk_ * 2) = rq[0]; *(LAS v4u*)((SB_) + O_Q + (c_ + 32) * 272 + kk_ * 2) = rq[1]; \
              *(LAS v4u*)((SB_) + O_K + c_ * 272 + kk_ * 2) = rk[0]; *(LAS v4u*)((SB_) + O_K + (c_ + 32) * 272 + kk_ * 2) = rk[1]; } \
            { const int c_ = tid >> 3, jj_ = (tid & 7) * 8; *(LAS v4u*)((SB_) + O_T + c_ * 144 + jj_ * 2) = rt; *(LAS v4u*)((SB_) + O_A + c_ * 144 + jj_ * 2) = ra; } \
            if (tid < 256) *(LAS v4u*)((SB_) + O_V + (tid >> 2) * 64 + (tid & 3) * 16) = rv; \
            if (tid < 64) *(LAS f32x4*)((SB_) + O_VEC + tid * 16) = rvec; } while (0)
        DN_LOAD(0); DN_STORE(lds); DN_LOAD(1);
        LDS_BARRIER();
        for (int n = 0; n < 36; ++n) {
            LAS unsigned char* B = lds + (n & 1) * BUF;
            if (n + 1 < 36) { DN_STORE(lds + ((n + 1) & 1) * BUF); if (n + 2 < 36) DN_LOAD(n + 2); }
            const int ck = chunk_of(n); const size_t row0 = ck < 4 ? (size_t)ML + b * CTXL + ck * 64 : (size_t)b * SEQ + (ck - 4) * 64;
            const int mt = wave >> 1, nt = wave & 1;
            const LAS float* vec = (const LAS float*)(B + O_VEC);
            const int cb = mt * 16 + (lane >> 4) * 4, vv = nt * 16 + (lane & 15);
            f32x4 ksa = {0.f, 0.f, 0.f, 0.f}, qsa = ksa;
#pragma unroll
            for (int ks = 0; ks < 4; ++ks) { const bf16x8 fk = ldfrag(B + O_K, 272, mt * 16, ks * 32, lane), fq = ldfrag(B + O_Q, 272, mt * 16, ks * 32, lane), fs = ldfrag(lds + O_ST, 272, nt * 16, ks * 32, lane);
                ksa = MFMA16(fk, fs, ksa); qsa = MFMA16(fq, fs, qsa); }
            {
                const f32x4 eg = *(const LAS f32x4*)(vec + cb), be = *(const LAS f32x4*)(vec + 64 + cb);
                float rr[4];
#pragma unroll
                for (int i = 0; i < 4; ++i) { const float vval = bf2f(*(const LAS bf16*)(B + O_V + (cb + i) * 64 + vv * 2)); rr[i] = be[i] * (vval - eg[i] * ksa[i]); qsa[i] *= eg[i]; }
                v2u p; p.x = pk2(rr[0], rr[1]); p.y = pk2(rr[2], rr[3]);
                *(LAS v2u*)(lds + O_RT + vv * 144 + cb * 2) = p;
            }
            LDS_BARRIER();
            {
                f32x4 vn = {0.f, 0.f, 0.f, 0.f};
#pragma unroll
                for (int ks = 0; ks < 2; ++ks) { const bf16x8 ft = ldfrag(B + O_T, 144, mt * 16, ks * 32, lane), fr = ldfrag(lds + O_RT, 144, nt * 16, ks * 32, lane); vn = MFMA16(ft, fr, vn); }
                const f32x4 w = *(const LAS f32x4*)(vec + 128 + cb);
                v2u p, q; p.x = pk2(vn[0], vn[1]); p.y = pk2(vn[2], vn[3]); q.x = pk2(vn[0] * w[0], vn[1] * w[1]); q.y = pk2(vn[2] * w[2], vn[3] * w[3]);
                *(LAS v2u*)(lds + O_VN + vv * 144 + cb * 2) = p; *(LAS v2u*)(lds + O_VW + vv * 144 + cb * 2) = q;
            }
            LDS_BARRIER();
            {
#pragma unroll
                for (int ks = 0; ks < 2; ++ks) { const bf16x8 fa = ldfrag(B + O_A, 144, mt * 16, ks * 32, lane), fv = ldfrag(lds + O_VN, 144, nt * 16, ks * 32, lane); qsa = MFMA16(fa, fv, qsa); }
#pragma unroll
                for (int i = 0; i < 4; ++i) Og[(row0 + cb + i) * 512 + vv] = (bf16)f2bf(qsa[i]);
                const float gt = vec[192];
                S0 = S0 * gt; S1 = S1 * gt;
#pragma unroll
                for (int ks = 0; ks < 2; ++ks) { const bf16x8 fkt = ldfrag_tr(B + O_K, 272, ks * 32, wave * 16, lane), fw0 = ldfrag(lds + O_VW, 144, 0, ks * 32, lane), fw1 = ldfrag(lds + O_VW, 144, 16, ks * 32, lane);
                    S0 = MFMA16(fkt, fw0, S0); S1 = MFMA16(fkt, fw1, S1); }
                v2u p0, p1; p0.x = pk2(S0[0], S0[1]); p0.y = pk2(S0[2], S0[3]); p1.x = pk2(S1[0], S1[1]); p1.y = pk2(S1[2], S1[3]);
                const int kb = wave * 16 + (lane >> 4) * 4;
                *(LAS v2u*)(lds + O_ST + (lane & 15) * 272 + kb * 2) = p0; *(LAS v2u*)(lds + O_ST + (16 + (lane & 15)) * 272 + kb * 2) = p1;
            }
            LDS_BARRIER();
        }
#undef chunk_of
#undef DN_LOAD
#undef DN_STORE
    }
}

template <bool FINAL> DI void rg_phase(const Args& a, LAS unsigned char* lds, int vcu0, int G) {
    const int vcu = FINAL ? vcu0 : (vcu0 + G / 2) % G;
    const int tid = tid_fresh(), lane = tid & 63, wave = __builtin_amdgcn_readfirstlane(tid >> 6);
    unsigned char* ws = a.ws;
    const bf16* U = (const bf16*)(ws + WS_U);
    float* SUM = (float*)(ws + WS_RGSUM);
    LAS unsigned char* UAs = lds;
    LAS float* scr = (LAS float*)(lds + 33280 + wave * 8192);
    LAS float* carry_s = (LAS float*)(lds + 33280 + 65536);
    const int cp = (tid & 255) * 2, hf = tid >> 8;
    float cwv[4][2];
#pragma unroll
    for (int j = 0; j < 4; ++j) { cwv[j][0] = a.in[I_ACONVW][j * 512 + cp]; cwv[j][1] = a.in[I_ACONVW][j * 512 + cp + 1]; }
    const float cb0 = a.in[I_ACONVB][cp], cb1 = a.in[I_ACONVB][cp + 1];
    const int blk = wave, cl = lane & 15, q4 = (lane >> 4) * 4;
    float gbr[2][4], gbi[2][4], c1[2][4];
#pragma unroll
    for (int d = 0; d < 2; ++d)
#pragma unroll
        for (int nt = 0; nt < 4; ++nt) { const int ch = blk * 64 + nt * 16 + cl;
            gbr[d][nt] = -1.4426950408889634f * a.in[I_AGATEB][(d * 2 + 0) * 512 + ch]; gbi[d][nt] = -1.4426950408889634f * a.in[I_AGATEB][(d * 2 + 1) * 512 + ch];
            c1[d][nt] = -8.0f * 1.4426950408889634f * softplus_(-a.in[I_ALAM][d * 512 + ch]); }
    const bf16* GWT = (const bf16*)(ws + WS_GWT);
    unsigned xs[19]; float cpre0 = 0.f, cpre1 = 0.f;
#define RG_FETCH(u_) do { const int b_ = (u_) / 72, ck_ = (u_) - b_ * 72; const int row0_ = ck_ < 8 ? ML + b_ * CTXL + ck_ * 32 : b_ * SEQ + (ck_ - 8) * 32, seg0_ = ck_ < 8 ? ML + b_ * CTXL : b_ * SEQ, len_ = ck_ < 8 ? CTXL : SEQ, t0_ = row0_ - seg0_; \
        _Pragma("unroll") for (int i_ = 0; i_ < 19; ++i_) { const int tt_ = t0_ + hf * 16 + i_ - 2; xs[i_] = (tt_ >= 0 && tt_ < len_) ? *(const unsigned*)(U + (size_t)(seg0_ + tt_) * NU0S + cp) : 0u; } \
        if (FINAL) { const float* cg_ = (const float*)(ws + WS_RGCARRY) + ((size_t)b_ * 72 + ck_) * 1024; cpre0 = cg_[tid]; cpre1 = cg_[tid + 512]; } } while (0)
    int u = vcu;
    if (u < 576) RG_FETCH(u);
    for (; u < 576; u += G) {
        const int b = u / 72, ck = u - b * 72;
        const int row0 = ck < 8 ? ML + b * CTXL + ck * 32 : b * SEQ + (ck - 8) * 32;
        LDS_BARRIER();
#pragma unroll
        for (int i = 0; i < 16; ++i) { float a0 = cb0, a1 = cb1;
#pragma unroll
            for (int j = 0; j < 4; ++j) { a0 += cwv[j][0] * bflo(xs[i + j]); a1 += cwv[j][1] * bfhi(xs[i + j]); }
            *(LAS unsigned*)(UAs + (hf * 16 + i) * 1040 + cp * 2) = pk2(a0, a1); }
        if (FINAL) { carry_s[tid] = cpre0; carry_s[tid + 512] = cpre1; }
        if (u + G < 576) RG_FETCH(u + G);
        LDS_BARRIER();
        bf16x8 fa[2][2];
#pragma unroll
        for (int mt = 0; mt < 2; ++mt)
#pragma unroll
            for (int ks = 0; ks < 2; ++ks) fa[mt][ks] = ldfrag(UAs, 1040, mt * 16, blk * 64 + ks * 32, lane);
        bf16x8 wf[2][2][2];
#define RG_LOADW(nt_) do { _Pragma("unroll") for (int d_ = 0; d_ < 2; ++d_) _Pragma("unroll") for (int g_ = 0; g_ < 2; ++g_) _Pragma("unroll") for (int ks_ = 0; ks_ < 2; ++ks_) \
            wf[d_][g_][ks_] = *(const bf16x8*)(GWT + (size_t)((d_ * 2 + g_) * 8 + blk) * 4096 + ((nt_) * 16 + cl) * 64 + ks_ * 32 + (lane >> 4) * 8); } while (0)
        RG_LOADW(0);
#pragma unroll 1
        for (int nt = 0; nt < 4; ++nt) {
            bf16 ayv[8];
            if (FINAL) {
#pragma unroll
                for (int e = 0; e < 8; ++e) { const int idx = e * 64 + lane; ayv[e] = U[(size_t)(row0 + (idx >> 4)) * NU0S + 512 + blk * 64 + nt * 16 + (idx & 15)]; } }
            bf16x8 wn[2][2];
#pragma unroll
            for (int g_ = 0; g_ < 2; ++g_)
#pragma unroll
                for (int ks_ = 0; ks_ < 2; ++ks_) wn[g_][ks_] = wf[1][g_][ks_];
#pragma unroll
            for (int d = 0; d < 2; ++d) {
                const float gbr_ = nt == 0 ? gbr[d][0] : (nt == 1 ? gbr[d][1] : (nt == 2 ? gbr[d][2] : gbr[d][3]));
                const float gbi_ = nt == 0 ? gbi[d][0] : (nt == 1 ? gbi[d][1] : (nt == 2 ? gbi[d][2] : gbi[d][3]));
                const float c1_ = nt == 0 ? c1[d][0] : (nt == 1 ? c1[d][1] : (nt == 2 ? c1[d][2] : c1[d][3]));
                f32x4 ar[2], ai[2];
#pragma unroll
                for (int mt = 0; mt < 2; ++mt) { ar[mt] = (f32x4){0.f, 0.f, 0.f, 0.f}; ai[mt] = ar[mt];
#pragma unroll
                    for (int ks = 0; ks < 2; ++ks) { ar[mt] = MFMA16(fa[mt][ks], d ? wn[0][ks] : wf[0][0][ks], ar[mt]); ai[mt] = MFMA16(fa[mt][ks], d ? wn[1][ks] : wf[0][1][ks], ai[mt]); } }
                if (d == 1 && nt < 3) RG_LOADW(nt + 1);
                float av8[2][4], xv8[2][4];
#pragma unroll
                for (int mt = 0; mt < 2; ++mt)
#pragma unroll
                    for (int i = 0; i < 4; ++i) { const int c = mt * 16 + q4 + i;
                        const float rr = frcp(1.0f + __builtin_amdgcn_exp2f(ar[mt][i] * -1.4426950408889634f + gbr_));
                        const float ig = frcp(1.0f + __builtin_amdgcn_exp2f(ai[mt][i] * -1.4426950408889634f + gbi_));
                        const float av = __builtin_amdgcn_exp2f(c1_ * rr), ua = bf2f(*(const LAS bf16*)(UAs + c * 1040 + (blk * 64 + nt * 16 + cl) * 2));
                        const float xv = __builtin_amdgcn_sqrtf(fmaxf(1.0f - av * av, 0.f)) * (ig * ua);
                        av8[mt][i] = av; xv8[mt][i] = xv;
                        if (FINAL) { scr[((d * 2 + 0) * 32 + c) * 16 + cl] = av; scr[((d * 2 + 1) * 32 + c) * 16 + cl] = xv; }
                        if (!FINAL) ((unsigned*)(ws + WS_RGAX))[((size_t)d * M0 + row0 + c) * 512 + blk * 64 + nt * 16 + cl] = (unsigned)__builtin_bit_cast(unsigned short, (_Float16)(1.0f - av)) | ((unsigned)__builtin_bit_cast(unsigned short, (_Float16)xv) << 16); }
                if (!FINAL) {
                    float P[2], H[2];
#pragma unroll
                    for (int mt = 0; mt < 2; ++mt) { float p = 1.f, hh = 0.f;
#pragma unroll
                        for (int s = 0; s < 4; ++s) { const int i = d ? 3 - s : s; hh = av8[mt][i] * hh + xv8[mt][i]; p *= av8[mt][i]; }
#pragma unroll
                        for (int st = 0; st < 2; ++st) { const int bit = st ? 2 : 1; const float po = __shfl_xor(p, 16 * bit), ho = __shfl_xor(hh, 16 * bit);
                            const bool mine_first = (((lane >> 4) & bit) == 0) != (d == 1);
                            const float pe = mine_first ? p : po, he = mine_first ? hh : ho, pl = mine_first ? po : p, hl = mine_first ? ho : hh;
                            p = pl * pe; hh = pl * he + hl; }
                        P[mt] = p; H[mt] = hh; }
                    const float pe = d ? P[1] : P[0], he = d ? H[1] : H[0], pl = d ? P[0] : P[1], hl = d ? H[0] : H[1];
                    if (lane < 16) { float* sp = SUM + ((size_t)(d * 8 + b) * 72 + ck) * 1024 + (blk * 64 + nt * 16 + cl) * 2; sp[0] = pl * pe; sp[1] = pl * he + hl; }
                }
            }
            if (!FINAL) continue;
            __builtin_amdgcn_wave_barrier(); LDS_WAIT();
            if (lane < 32) { const int d = lane >> 4, chh = blk * 64 + nt * 16 + cl;
                float hh = FINAL ? carry_s[d * 512 + chh] : 0.f, P = 1.f;
#pragma unroll 8
                for (int s = 0; s < 32; ++s) { const int c = d ? 31 - s : s; const float av = scr[((d * 2 + 0) * 32 + c) * 16 + cl], xv = scr[((d * 2 + 1) * 32 + c) * 16 + cl];
                    hh = av * hh + xv; if (FINAL) scr[((d * 2 + 1) * 32 + c) * 16 + cl] = hh; else P *= av; }
                if (!FINAL) { float* sp = SUM + ((size_t)(d * 8 + b) * 72 + ck) * 1024 + chh * 2; sp[0] = P; sp[1] = hh; } }
            __builtin_amdgcn_wave_barrier(); LDS_WAIT();
            if (FINAL) {
                bf16* Y = (bf16*)(ws + WS_Y);
#pragma unroll
                for (int e = 0; e < 8; ++e) { const int idx = e * 64 + lane, c = idx >> 4, c2 = idx & 15, chh = blk * 64 + nt * 16 + c2;
                    const float hs = scr[((0 * 2 + 1) * 32 + c) * 16 + c2] + scr[((1 * 2 + 1) * 32 + c) * 16 + c2];
                    Y[(size_t)(row0 + c) * D + chh] = (bf16)f2bf(hs * gelu_tanh(bf2f(ayv[e]))); }
            }
            __builtin_amdgcn_wave_barrier(); LDS_WAIT();
        }
#undef RG_LOADW
    }
#undef RG_FETCH
}

DI void rg_carry_phase(const Args& a, int vcu, int G) {
    const int tid = tid_fresh();
    unsigned char* ws = a.ws;
    const float* SUM = (const float*)(ws + WS_RGSUM); float* CARRY = (float*)(ws + WS_RGCARRY);
    if (tid >= 64) return;
    for (int cidx = vcu * 64 + tid; cidx < 8192; cidx += G * 64) {
        const int ch = cidx & 511, d = (cidx >> 9) & 1, b = cidx >> 10;
        const float* sp = SUM + (size_t)(d * 8 + b) * 72 * 1024 + ch * 2;
        float* cp = CARRY + (size_t)b * 72 * 1024 + d * 512 + ch;
        float carry = 0.f;
#pragma unroll 1
        for (int p0 = 0; p0 < 72; p0 += 12) {
            typedef float f32x2_ __attribute__((ext_vector_type(2)));
            f32x2_ ph[12]; int ee[12];
#pragma unroll
            for (int q = 0; q < 12; ++q) { const int p = p0 + q; ee[q] = d == 0 ? p : (p < 8 ? 7 - p : 71 - (p - 8)); ph[q] = *(const f32x2_*)(sp + ee[q] * 1024); }
#pragma unroll
            for (int q = 0; q < 12; ++q) { cp[(size_t)ee[q] * 1024] = carry; carry = ph[q].x * carry + ph[q].y; }
        }
    }
}

DI void rg_final_phase(const Args& a, int vcu, int G) {
    const int tid = tid_fresh();
    unsigned char* ws = a.ws;
    const bf16* U = (const bf16*)(ws + WS_U); bf16* Y = (bf16*)(ws + WS_Y);
    const unsigned* AX0 = (const unsigned*)(ws + WS_RGAX); const unsigned* AX1 = AX0 + (size_t)M0 * 512;
    for (int u = vcu; u < 576; u += G) {
        const int b = u / 72, ck = u - b * 72;
        const size_t row0 = ck < 8 ? (size_t)ML + b * CTXL + ck * 32 : (size_t)b * SEQ + (ck - 8) * 32;
        const float* cg = (const float*)(ws + WS_RGCARRY) + ((size_t)b * 72 + ck) * 1024;
        float h0 = cg[tid], h1 = cg[512 + tid];
        unsigned w0[32], w1[32]; bf16 ay[32];
#pragma unroll
        for (int c = 0; c < 32; ++c) { w0[c] = AX0[(row0 + c) * 512 + tid]; w1[c] = AX1[(row0 + c) * 512 + tid]; ay[c] = U[(row0 + c) * NU0S + 512 + tid]; }
        float hf[32];
#pragma unroll
        for (int c = 0; c < 32; ++c) { const float om = (float)__builtin_bit_cast(_Float16, (unsigned short)(w0[c] & 0xffff)), xv = (float)__builtin_bit_cast(_Float16, (unsigned short)(w0[c] >> 16)); h0 = (h0 - om * h0) + xv; hf[c] = h0; }
#pragma unroll
        for (int c = 31; c >= 0; --c) { const float om = (float)__builtin_bit_cast(_Float16, (unsigned short)(w1[c] & 0xffff)), xv = (float)__builtin_bit_cast(_Float16, (unsigned short)(w1[c] >> 16)); h1 = (h1 - om * h1) + xv;
            Y[(row0 + c) * D + tid] = (bf16)f2bf((hf[c] + h1) * gelu_tanh(bf2f(ay[c]))); }
    }
}


DI void merge0_phase(const Args& a, int vcu, int G) {
    const int tid = tid_fresh(), lane = tid & 63, wave = __builtin_amdgcn_readfirstlane(tid >> 6);
    const int heavy = 0;
    if (vcu < heavy) return;
    const int gw = (vcu - heavy) * NWAVES + wave, NGW = (G - heavy) * NWAVES;
    unsigned char* ws = a.ws;
    const bf16* U = (const bf16*)(ws + WS_U); bf16* Y = (bf16*)(ws + WS_Y);
    const bf16* O0 = (const bf16*)(ws + WS_DNO); const bf16* O1 = O0 + (size_t)M0 * 512;
    const int c0 = 8 * lane;
    float ng[8];
#pragma unroll
    for (int i = 0; i < 8; ++i) ng[i] = a.in[I_BNORMG][(c0 & 127) + i];
    for (int r = gw; r < M0; r += NGW) {
        const size_t o = (size_t)r * 512 + c0;
        const v4u x0 = *(const v4u*)(O0 + o), x1 = *(const v4u*)(O1 + o);
        const f32x4 oa = {bflo(x0.x) + bflo(x1.x), bfhi(x0.x) + bfhi(x1.x), bflo(x0.y) + bflo(x1.y), bfhi(x0.y) + bfhi(x1.y)}, ob = {bflo(x0.z) + bflo(x1.z), bfhi(x0.z) + bfhi(x1.z), bflo(x0.w) + bflo(x1.w), bfhi(x0.w) + bfhi(x1.w)};
        float ss = (oa.x * oa.x + oa.y * oa.y) + (oa.z * oa.z + oa.w * oa.w) + (ob.x * ob.x + ob.y * ob.y) + (ob.z * ob.z + ob.w * ob.w);
        ss = sum16(ss);
        const float rs = rsqrtf(ss * (1.0f / 128.0f) + EPS);
        const v4u z = *(const v4u*)(U + (size_t)r * NU0S + 2560 + c0);
        v4u y;
        y.x = pk2(oa.x * rs * ng[0] * silu_(bflo(z.x)), oa.y * rs * ng[1] * silu_(bfhi(z.x))); y.y = pk2(oa.z * rs * ng[2] * silu_(bflo(z.y)), oa.w * rs * ng[3] * silu_(bfhi(z.y)));
        y.z = pk2(ob.x * rs * ng[4] * silu_(bflo(z.z)), ob.y * rs * ng[5] * silu_(bfhi(z.z))); y.w = pk2(ob.z * rs * ng[6] * silu_(bflo(z.w)), ob.w * rs * ng[7] * silu_(bfhi(z.w)));
        *(v4u*)(Y + (size_t)r * D + 512 + c0) = y;
    }
}

DI void merge1_phase(const Args& a, int vcu, int G) {
    const int tid = tid_fresh(), lane = tid & 63, wave = __builtin_amdgcn_readfirstlane(tid >> 6);
    const int gw = vcu * NWAVES + wave, NGW = G * NWAVES;
    unsigned char* ws = a.ws;
    const bf16* U = (const bf16*)(ws + WS_U); bf16* Y = (bf16*)(ws + WS_Y);
    const bf16* O0 = (const bf16*)(ws + WS_O1); const bf16* O1 = O0 + (size_t)ML * 1024;
    const int c0 = 16 * lane;
    const float* ngp = c0 < 512 ? a.in[I_CNORMG] : a.in[I_DNORMG];
    const int gcol = c0 < 512 ? 2048 + c0 : 3584 + (c0 - 512);
    float ng[16];
#pragma unroll
    for (int i = 0; i < 16; ++i) ng[i] = ngp[(c0 & 127) + i];
    for (int r = gw; r < ML; r += NGW) {
        float o[16]; float ss = 0.f;
#pragma unroll
        for (int hh = 0; hh < 2; ++hh) { const v4u x0 = *(const v4u*)(O0 + (size_t)r * 1024 + c0 + 8 * hh), x1 = *(const v4u*)(O1 + (size_t)r * 1024 + c0 + 8 * hh);
            o[8 * hh + 0] = bflo(x0.x) + bflo(x1.x); o[8 * hh + 1] = bfhi(x0.x) + bfhi(x1.x); o[8 * hh + 2] = bflo(x0.y) + bflo(x1.y); o[8 * hh + 3] = bfhi(x0.y) + bfhi(x1.y);
            o[8 * hh + 4] = bflo(x0.z) + bflo(x1.z); o[8 * hh + 5] = bfhi(x0.z) + bfhi(x1.z); o[8 * hh + 6] = bflo(x0.w) + bflo(x1.w); o[8 * hh + 7] = bfhi(x0.w) + bfhi(x1.w); }
#pragma unroll
        for (int i = 0; i < 16; ++i) ss += o[i] * o[i];
        ss = sum8(ss);
        const float rs = rsqrtf(ss * (1.0f / 128.0f) + EPS);
#pragma unroll
        for (int hh = 0; hh < 2; ++hh) { const v4u z = *(const v4u*)(U + (size_t)r * NU1S + gcol + 8 * hh); const float* oo = o + 8 * hh; const float* gg = ng + 8 * hh;
            v4u y;
            y.x = pk2(oo[0] * rs * gg[0] * silu_(bflo(z.x)), oo[1] * rs * gg[1] * silu_(bfhi(z.x))); y.y = pk2(oo[2] * rs * gg[2] * silu_(bflo(z.y)), oo[3] * rs * gg[3] * silu_(bfhi(z.y)));
            y.z = pk2(oo[4] * rs * gg[4] * silu_(bflo(z.z)), oo[5] * rs * gg[5] * silu_(bfhi(z.z))); y.w = pk2(oo[6] * rs * gg[6] * silu_(bflo(z.w)), oo[7] * rs * gg[7] * silu_(bfhi(z.w)));
            *(v4u*)(Y + (size_t)r * D + c0 + 8 * hh) = y; }
    }
}

DI void moe_offsets(const unsigned* ctl, int (&off)[NEXP + 1]) {
    off[0] = 0;
#pragma unroll
    for (int e = 0; e < NEXP; ++e) { const unsigned c = __hip_atomic_load(ctl + CW_CNT + 64 * e, RLX_AGENT); off[e + 1] = off[e] + (int)((c + 255u) & ~255u); }
}
DI void moe_sort_phase(const Args& a, int vcu, int G) {
    const int tid = tid_fresh(), lane = tid & 63, wave = __builtin_amdgcn_readfirstlane(tid >> 6);
    const int gw = vcu * NWAVES + wave, NGW = G * NWAVES;
    unsigned char* ws = a.ws;
    unsigned* ctl = (unsigned*)(ws + WS_CTL);
    int off[NEXP + 1]; moe_offsets(ctl, off);
    if (blockIdx.x == 0 && tid < 160) {
        const int nt = off[NEXP] >> 8; int e = 0;
#pragma unroll
        for (int q = 1; q < NEXP; ++q) e += (tid * 256 >= off[q]) ? 1 : 0;
        ctl[CW_TILE_E + tid] = (unsigned)(tid < nt ? e : 0);
        if (tid == 0) { ctl[CW_NTILES] = (unsigned)nt;
            const int U4 = nt * 4, Gn = (int)gridDim.x; int F = (U4 / Gn) * Gn; const int R = U4 - F; int S = 1; if (R > 0 && R <= 32 && Gn >= 8 * R) S = 8; else if (R > 0 && R <= 64 && Gn >= 4 * R) S = 4; if (S == 1) F = U4;
#ifdef FORCE_S
            S = 1; F = U4; if (FORCE_S > 1 && R > 0 && R <= (FORCE_S == 8 ? 32 : 64)) { S = FORCE_S; F = (U4 / Gn) * Gn; }
#endif
            ctl[CW_TAILF] = (unsigned)F; ctl[CW_TAILS] = (unsigned)S; }
    }
    const bf16* XN2 = (const bf16*)(ws + WS_XN2); bf16* XS = (bf16*)(ws + WS_XS);
    for (int t = gw; t < ML; t += NGW) {
        unsigned* tk = (unsigned*)(ws + WS_TOPK) + (size_t)t * 8;
        const int e0 = (int)tk[0], e1 = (int)tk[1];
        int o0 = 0, o1 = 0;
#pragma unroll
        for (int q = 0; q < NEXP; ++q) { o0 = (e0 == q) ? off[q] : o0; o1 = (e1 == q) ? off[q] : o1; }
        const int p0 = o0 + (int)tk[4], p1 = o1 + (int)tk[5];
        const v4u x0 = *(const v4u*)(XN2 + (size_t)t * D + 8 * lane), x1 = *(const v4u*)(XN2 + (size_t)t * D + 512 + 8 * lane);
        *(v4u*)(XS + (size_t)p0 * D + 8 * lane) = x0; *(v4u*)(XS + (size_t)p0 * D + 512 + 8 * lane) = x1;
        *(v4u*)(XS + (size_t)p1 * D + 8 * lane) = x0; *(v4u*)(XS + (size_t)p1 * D + 512 + 8 * lane) = x1;
        if (lane == 0) { tk[6] = (unsigned)p0; tk[7] = (unsigned)p1; }
    }
}
DI void final_phase(const Args& a, int vcu, int G) {
    const int tid = tid_fresh(), lane = tid & 63, wave = __builtin_amdgcn_readfirstlane(tid >> 6);
    const int gw = vcu * NWAVES + wave, NGW = G * NWAVES;
    unsigned char* ws = a.ws;
    const bf16* OUTS = (const bf16*)(ws + WS_OUTS); const float* MOD = (const float*)(ws + WS_MOD);
    const unsigned* ctl = (const unsigned*)(ws + WS_CTL);
    const int tS = (int)__hip_atomic_load(ctl + CW_TAILS, RLX_AGENT), tail_row0 = tS > 1 ? ((int)__hip_atomic_load(ctl + CW_TAILF, RLX_AGENT) / 4) * 256 : 0x7fffffff;
    f32x4 fg[4];
#pragma unroll
    for (int j = 0; j < 4; ++j) fg[j] = *(const f32x4*)(a.in[I_FINALG] + 4 * lane + 256 * j);
    for (int tb = gw; tb < ML; tb += 2 * NGW) {
        f32x4 v[2][4]; float ss[2] = {0.f, 0.f};
#pragma unroll
        for (int q = 0; q < 2; ++q) { const int t = tb + q * NGW;
            if (t < ML) {
                const unsigned* tk = (const unsigned*)(ws + WS_TOPK) + (size_t)t * 8;
                const float p0 = __builtin_bit_cast(float, tk[2]), p1 = __builtin_bit_cast(float, tk[3]); const int r0 = (int)tk[6], r1 = (int)tk[7];
                const float* gate = MOD + (size_t)(9 + (t >> 11)) * 6144 + 5 * 1024;
                const float* hp = a.out + (size_t)t * D;
                f32x4 y0[4], y1[4];
                if (__builtin_amdgcn_readfirstlane(r0) >= tail_row0) {
#pragma unroll
                    for (int j = 0; j < 4; ++j) y0[j] = (f32x4){0.f, 0.f, 0.f, 0.f};
                    for (int s = 0; s < tS; ++s) { const float* pb = pg8::moe_part_base(ws, s, tS) + (size_t)(r0 - tail_row0) * D + 4 * lane;
#pragma unroll
                        for (int j = 0; j < 4; ++j) y0[j] += *(const f32x4*)(pb + 256 * j); }
#pragma unroll
                    for (int j = 0; j < 4; ++j) { const unsigned w0 = pk2(y0[j].x, y0[j].y), w1 = pk2(y0[j].z, y0[j].w); y0[j] = (f32x4){bflo(w0), bfhi(w0), bflo(w1), bfhi(w1)}; }
                } else {
#pragma unroll
                    for (int j = 0; j < 4; ++j) { const v2u x = *(const v2u*)(OUTS + (size_t)r0 * D + 4 * lane + 256 * j); y0[j] = (f32x4){bflo(x.x), bfhi(x.x), bflo(x.y), bfhi(x.y)}; } }
                if (__builtin_amdgcn_readfirstlane(r1) >= tail_row0) {
#pragma unroll
                    for (int j = 0; j < 4; ++j) y1[j] = (f32x4){0.f, 0.f, 0.f, 0.f};
                    for (int s = 0; s < tS; ++s) { const float* pb = pg8::moe_part_base(ws, s, tS) + (size_t)(r1 - tail_row0) * D + 4 * lane;
#pragma unroll
                        for (int j = 0; j < 4; ++j) y1[j] += *(const f32x4*)(pb + 256 * j); }
#pragma unroll
                    for (int j = 0; j < 4; ++j) { const unsigned w0 = pk2(y1[j].x, y1[j].y), w1 = pk2(y1[j].z, y1[j].w); y1[j] = (f32x4){bflo(w0), bfhi(w0), bflo(w1), bfhi(w1)}; }
                } else {
#pragma unroll
                    for (int j = 0; j < 4; ++j) { const v2u x = *(const v2u*)(OUTS + (size_t)r1 * D + 4 * lane + 256 * j); y1[j] = (f32x4){bflo(x.x), bfhi(x.x), bflo(x.y), bfhi(x.y)}; } }
#pragma unroll
                for (int j = 0; j < 4; ++j) { const int k = 4 * lane + 256 * j;
                    v[q][j] = *(const f32x4*)(hp + k) + *(const f32x4*)(gate + k) * (y0[j] * p0 + y1[j] * p1);
                    ss[q] += (v[q][j].x * v[q][j].x + v[q][j].y * v[q][j].y) + (v[q][j].z * v[q][j].z + v[q][j].w * v[q][j].w); }
            } }
#pragma unroll
        for (int q = 0; q < 2; ++q) ss[q] = wave_sum(ss[q]);
#pragma unroll
        for (int q = 0; q < 2; ++q) { const int t = tb + q * NGW;
            if (t < ML) { const float rstd = rsqrtf(ss[q] * (1.0f / D) + EPS); float* hp = a.out + (size_t)t * D;
#pragma unroll
                for (int j = 0; j < 4; ++j) *(f32x4*)(hp + 4 * lane + 256 * j) = v[q][j] * rstd * fg[j]; } }
    }
}

constexpr int RING_BYTES = 153600, MISC_OFF = RING_BYTES, LDS_BYTES = RING_BYTES + 512;
enum { PH_PRO = 0, PH_NORM0, PH_GIN0, PH_PREP0, PH_SCAN0, PH_MERGE0, PH_GOUT0, PH_NORMF0, PH_GGU0, PH_GDN0, PH_NORM1, PH_GIN1, PH_PREP1, PH_CHAIN1, PH_MERGE1, PH_GOUT1, PH_NORMF1, PH_SORT, PH_MGU, PH_MDN, PH_FINAL, NPHASE };
__global__ void __launch_bounds__(NT, 2) mk_fwd(Args a) {
    extern __shared__ __attribute__((aligned(16))) unsigned char lds_raw[];
    LAS unsigned char* lds = (LAS unsigned char*)lds_raw;
    const int tid = tid_fresh();
    const int G = gridDim.x, bx = blockIdx.x, vcu = (G % 8 == 0) ? (bx % 8) * (G / 8) + bx / 8 : bx;
    unsigned char* ws = a.ws;
    volatile LAS unsigned* MISC = (volatile LAS unsigned*)(lds + MISC_OFF);
    for (int u = tid; u < (LDS_BYTES - RING_BYTES) / 4; u += NT) ((LAS unsigned*)(lds + RING_BYTES))[u] = 0u;
    __syncthreads();
    const int lo = a.ph_lo, hi = a.ph_hi;
    XcdBarrier bar; bar.bar = (unsigned*)(ws + WS_CTL) + CW_BAR; bar.x = 0; bar.st = nullptr;
    if (hi - lo > 1) bar = xcd_barrier_post((unsigned*)(ws + WS_CTL) + CW_BAR, MISC + 8);
#define IN(k) (lo <= (k) && (k) < hi)
#if defined(SUBP) && SUBP == 9
#define SEAM(k) do { if (IN(k) && IN((k) + 1)) { xcd_barrier(bar); xcd_barrier(bar); } } while (0)
#else
#define SEAM(k) do { if (IN(k) && IN((k) + 1)) xcd_barrier(bar); } while (0)
#endif
#ifndef REP_MASK
#define REP_MASK 0u
#endif
#define REPS(k) (((REP_MASK >> (k)) & 1u) ? 2 : 1)
    using namespace pg8;
    if (IN(PH_PRO)) for (int rep_ = 0; rep_ < REPS(PH_PRO); ++rep_) { if (rep_) __syncthreads(); p0_prologue(a, lds, vcu, G); } SEAM(PH_PRO);
    if (IN(PH_NORM0)) for (int rep_ = 0; rep_ < REPS(PH_NORM0); ++rep_) { if (rep_) __syncthreads(); norm_phase<0>(a, lds, vcu, G); } SEAM(PH_NORM0);
    if (IN(PH_GIN0)) for (int rep_ = 0; rep_ < REPS(PH_GIN0); ++rep_) { if (rep_) __syncthreads(); Gemm g{(const bf16_t*)(ws + WS_XN), (const bf16_t*)(ws + WS_WIN0), 1024}; StaticOrder S; S.init(M0, NU0S, G, bx); EpiBf16 E{(bf16_t*)(ws + WS_U), NU0S};
        gemm_phase<EpiBf16, StaticOrder, true, true>(lds, g, S, E); } SEAM(PH_GIN0);
    if (IN(PH_PREP0)) for (int rep_ = 0; rep_ < REPS(PH_PREP0); ++rep_) { if (rep_) __syncthreads(); for (int u = vcu; u < 1152; u += G) dn_prep_unit(a, lds, u); rg_phase<false>(a, lds, vcu, G);
#if defined(SUBP) && SUBP == 1
        for (int u = vcu; u < 1152; u += G) dn_prep_unit(a, lds, u);
#endif
#if defined(SUBP) && SUBP == 6
        rg_phase<false>(a, lds, vcu, G);
#endif
        } SEAM(PH_PREP0);
    if (IN(PH_SCAN0)) for (int rep_ = 0; rep_ < REPS(PH_SCAN0); ++rep_) { if (rep_) __syncthreads(); dn_chain_phase(a, lds, vcu, G);
#if defined(SUBP) && SUBP == 2
        dn_chain_phase(a, lds, vcu, G);
#endif
        rg_carry_phase(a, vcu, G); } SEAM(PH_SCAN0);
    if (IN(PH_MERGE0)) for (int rep_ = 0; rep_ < REPS(PH_MERGE0); ++rep_) { if (rep_) __syncthreads(); rg_final_phase(a, vcu, G); merge0_phase(a, vcu, G); } SEAM(PH_MERGE0);
    if (IN(PH_GOUT0)) for (int rep_ = 0; rep_ < REPS(PH_GOUT0); ++rep_) { if (rep_) __syncthreads(); Gemm g{(const bf16_t*)(ws + WS_Y), (const bf16_t*)(ws + WS_WOUT0), 1024}; CtxSplitOrder<16, 4> S{G, vcu};
        EpiResid<0> E{a.in[I_X], a.out, a.in[I_CTX], (float*)(ws + WS_HCTX), (const float*)(ws + WS_MOD) + 2 * 1024, (float*)(ws + WS_PART0)};
        gemm_phase<EpiResid<0>, CtxSplitOrder<16, 4>, true, true>(lds, g, S, E); } SEAM(PH_GOUT0);
    if (IN(PH_NORMF0)) for (int rep_ = 0; rep_ < REPS(PH_NORMF0); ++rep_) { if (rep_) __syncthreads(); norm_phase<1>(a, lds, vcu, G); } SEAM(PH_NORMF0);
    if (IN(PH_GGU0)) for (int rep_ = 0; rep_ < REPS(PH_GGU0); ++rep_) { if (rep_) __syncthreads(); Gemm g{(const bf16_t*)(ws + WS_XN), (const bf16_t*)(ws + WS_WGU0), 1024}; StaticOrder S; S.init(M0, 2 * DFF, G, bx); EpiSwiGLU E{(bf16_t*)(ws + WS_U), DFF};
        gemm_phase<EpiSwiGLU, StaticOrder, true, true>(lds, g, S, E); } SEAM(PH_GGU0);
    if (IN(PH_GDN0)) for (int rep_ = 0; rep_ < REPS(PH_GDN0); ++rep_) { if (rep_) __syncthreads(); Gemm g{(const bf16_t*)(ws + WS_U), (const bf16_t*)(ws + WS_WDN0), DFF}; CtxSplitOrder<44, 8> S{G, vcu};
        EpiResid<0> E{a.out, a.out, (const float*)(ws + WS_HCTX), (float*)(ws + WS_HCTX), (const float*)(ws + WS_MOD) + 5 * 1024, (float*)(ws + WS_PART0)};
        gemm_phase<EpiResid<0>, CtxSplitOrder<44, 8>, true, true>(lds, g, S, E); } SEAM(PH_GDN0);
    if (IN(PH_NORM1)) for (int rep_ = 0; rep_ < REPS(PH_NORM1); ++rep_) { if (rep_) __syncthreads(); norm_phase<2>(a, lds, vcu, G); } SEAM(PH_NORM1);
    if (IN(PH_GIN1)) for (int rep_ = 0; rep_ < REPS(PH_GIN1); ++rep_) { if (rep_) __syncthreads(); Gemm g{(const bf16_t*)(ws + WS_XN), (const bf16_t*)(ws + WS_WIN1), 1024}; StaticOrder S; S.init(M0, NU1S, G, bx); EpiBf16 E{(bf16_t*)(ws + WS_U), NU1S};
        gemm_phase<EpiBf16, StaticOrder, true, true>(lds, g, S, E); } SEAM(PH_GIN1);
    if (IN(PH_PREP1)) for (int rep_ = 0; rep_ < REPS(PH_PREP1); ++rep_) { if (rep_) __syncthreads(); scan1_prep_phase(a, lds, vcu, G); } SEAM(PH_PREP1);
    if (IN(PH_CHAIN1)) for (int rep_ = 0; rep_ < REPS(PH_CHAIN1); ++rep_) { if (rep_) __syncthreads(); scan1_chain_phase(a, lds, vcu, G); } SEAM(PH_CHAIN1);
    if (IN(PH_MERGE1)) for (int rep_ = 0; rep_ < REPS(PH_MERGE1); ++rep_) { if (rep_) __syncthreads(); merge1_phase(a, vcu, G); } SEAM(PH_MERGE1);
    if (IN(PH_GOUT1)) for (int rep_ = 0; rep_ < REPS(PH_GOUT1); ++rep_) { if (rep_) __syncthreads(); Gemm g{(const bf16_t*)(ws + WS_Y), (const bf16_t*)(ws + WS_WOUT1), 1024}; StaticOrder S; S.init(ML, 1024, G, bx);
        EpiResid<1> E{a.out, a.out, nullptr, nullptr, (const float*)(ws + WS_MOD) + 9 * 6144 + 2 * 1024, nullptr};
        gemm_phase<EpiResid<1>, StaticOrder, true, true>(lds, g, S, E); } SEAM(PH_GOUT1);
    if (IN(PH_NORMF1)) for (int rep_ = 0; rep_ < REPS(PH_NORMF1); ++rep_) { if (rep_) __syncthreads(); norm_phase<3>(a, lds, vcu, G); __syncthreads(); moe_weight_copies(a, lds, vcu, G);
#if defined(SUBP) && SUBP == 8
        __syncthreads(); moe_weight_copies(a, lds, vcu, G);
#endif
        } SEAM(PH_NORMF1);
    if (IN(PH_SORT)) for (int rep_ = 0; rep_ < REPS(PH_SORT); ++rep_) { if (rep_) __syncthreads(); moe_sort_phase(a, vcu, G); } SEAM(PH_SORT);
    if (IN(PH_MGU)) for (int rep_ = 0; rep_ < REPS(PH_MGU); ++rep_) { if (rep_) __syncthreads(); const unsigned* ctl = (const unsigned*)(ws + WS_CTL);
        Gemm g{(const bf16_t*)(ws + WS_XS), (const bf16_t*)(ws + WS_WGU1), 1024}; const int ntl = (int)__hip_atomic_load(ctl + CW_NTILES, RLX_AGENT); GroupOrder S{(const int*)(ctl + CW_TILE_E), ntl, 22, G, vcu, 16, ntl * 22, 1}; EpiSwiGLU E{(bf16_t*)(ws + WS_ACTS), DFF};
        gemm_phase<EpiSwiGLU, GroupOrder, true, true>(lds, g, S, E); } SEAM(PH_MGU);
    if (IN(PH_MDN)) for (int rep_ = 0; rep_ < REPS(PH_MDN); ++rep_) { if (rep_) __syncthreads(); const unsigned* ctl = (const unsigned*)(ws + WS_CTL);
        Gemm g{(const bf16_t*)(ws + WS_ACTS), (const bf16_t*)(ws + WS_WDN1), DFF}; const int ntl = (int)__hip_atomic_load(ctl + CW_NTILES, RLX_AGENT), tF = (int)__hip_atomic_load(ctl + CW_TAILF, RLX_AGENT), tS = (int)__hip_atomic_load(ctl + CW_TAILS, RLX_AGENT);
        GroupOrder S{(const int*)(ctl + CW_TILE_E), ntl, 4, G, vcu, 44, tF, tS}; EpiF32 E{(bf16_t*)(ws + WS_OUTS), 1024, ws, (tF / 4) * 256, tS};
        gemm_phase<EpiF32, GroupOrder, true, true>(lds, g, S, E); } SEAM(PH_MDN);
    if (IN(PH_FINAL)) for (int rep_ = 0; rep_ < REPS(PH_FINAL); ++rep_) { if (rep_) __syncthreads(); final_phase(a, vcu, G); }
#undef IN
#undef SEAM
}

extern "C" void kernel_launch(void* const* d_in, const int* in_sizes, int n_in, void* d_out, int out_size, void* d_ws, size_t ws_size, hipStream_t stream) {
    static int grid = 0;
    if (grid == 0) {
        if (n_in != N_IN || out_size != ML * D || ws_size < WS_END) { fprintf(stderr, "kernel_launch: unexpected shapes (n_in %d out %d ws %zu)\n", n_in, out_size, ws_size); grid = -1; return; }
        int dev = 0, cus = 0, per_cu = 0;
        if (hipGetDevice(&dev) != hipSuccess || hipDeviceGetAttribute(&cus, hipDeviceAttributeMultiprocessorCount, dev) != hipSuccess) { grid = -1; return; }
        if (hipFuncSetAttribute((const void*)mk_fwd, hipFuncAttributeMaxDynamicSharedMemorySize, LDS_BYTES) != hipSuccess) { fprintf(stderr, "kernel_launch: hipFuncSetAttribute failed\n"); grid = -1; return; }
        if (hipOccupancyMaxActiveBlocksPerMultiprocessor(&per_cu, (const void*)mk_fwd, NT, LDS_BYTES) != hipSuccess || per_cu < 1) { fprintf(stderr, "kernel_launch: occupancy query says %d\n", per_cu); }
        (void)hipGetLastError();
        grid = cus;
    }
    if (grid < 0) return;
    if (hipMemsetAsync((char*)d_ws + WS_CTL, 0, CTL_ZERO_BYTES, stream) != hipSuccess) return;
    Args a{};
    for (int i = 0; i < N_IN; ++i) a.in[i] = (const float*)d_in[i];
    a.out = (float*)d_out; a.ws = (unsigned char*)d_ws;
#ifndef MK_SINGLE
    for (int p = 0; p < NPHASE; ++p) { a.ph_lo = p; a.ph_hi = p + 1; hipLaunchKernelGGL(mk_fwd, dim3(grid), dim3(NT), LDS_BYTES, stream, a); }
#else
    a.ph_lo = 0; a.ph_hi = NPHASE; hipLaunchKernelGGL(mk_fwd, dim3(grid), dim3(NT), LDS_BYTES, stream, a);
#endif
}
```
